# Optimizing an MI355X kernel written in HIP

```python
import math
import jax
import jax.numpy as jnp
from jax import lax
import numpy as np

D_MODEL = 2048
BATCH = 4
SEQ = 2048
DEPTH = 2
DEC_BATCH = 128
DEC_SEQ = 1
PAST_LEN = 8192
PAGE_SIZE = 128

MEM_LEN = 256
CHUNK = 128
G_GROUPS = 8
G_WIDTH = 768
G_GDIM = G_WIDTH // G_GROUPS
SWA_HEADS = 12
SWA_KV = 4
SWA_HD = 64
SWA_WIDTH = SWA_HEADS * SWA_HD
SWA_KV_WIDTH = SWA_KV * SWA_HD
WINDOW = 128
QBLOCK = 128
MEM_HEADS = 4
MEM_HD = 128
MEM_WIDTH = MEM_HEADS * MEM_HD
N_BRANCH = 3
D_FF = 5632
CONV_W = 3
EPS = 1e-6
N_IN = 2 * G_WIDTH + SWA_WIDTH + 2 * SWA_KV_WIDTH + MEM_WIDTH + N_BRANCH * D_MODEL

kernel_name = 'hybrid_gmlp_swa_mem_convffn_step'


def rmsnorm(x, g):
    xf = x.astype(jnp.float32)
    y = xf * lax.rsqrt(jnp.mean(xf * xf, axis=-1, keepdims=True) + EPS)
    return (y * g.astype(jnp.float32)).astype(x.dtype)


def alibi_slopes(n):
    p = 2 ** int(math.floor(math.log2(n)))
    base = [2.0 ** (-8.0 * (i + 1) / p) for i in range(p)]
    extra = [2.0 ** (-8.0 * (2 * i + 1) / (2 * p)) for i in range(n - p)]
    return jnp.asarray(base + extra, dtype=jnp.float32)


def gmlp_spatial(v, ws, bs):
    B, T, _ = v.shape
    L = min(CHUNK, T)
    nc = -(-T // L)
    tp = nc * L
    if tp > T:
        v = jnp.pad(v, ((0, 0), (0, tp - T), (0, 0)))
    vr = v.reshape(B, nc, L, G_GROUPS, G_GDIM)
    w = jnp.tril(ws[:, :L, :L])
    m = jnp.einsum('gts,bnsgc->bntgc', w, vr) + jnp.transpose(bs[:, :L])[None, None, :, :, None]
    return m.reshape(B, tp, G_WIDTH)[:, :T]


def swa_attention(q, k, v, prefix_k, prefix_v, start, sinks, slopes):
    B, T = q.shape[0], q.shape[1]
    G = SWA_HEADS // SWA_KV
    P = prefix_k.shape[1]
    if P < WINDOW:
        padw = ((0, 0), (WINDOW - P, 0), (0, 0), (0, 0))
        prefix_k = jnp.pad(prefix_k, padw)
        prefix_v = jnp.pad(prefix_v, padw)
    kcat = jnp.concatenate([prefix_k.astype(k.dtype), k], axis=1)
    vcat = jnp.concatenate([prefix_v.astype(v.dtype), v], axis=1)
    new_k_buf = kcat[:, T:]
    new_v_buf = vcat[:, T:]
    qb = min(QBLOCK, T)
    nb = -(-T // qb)
    tp = nb * qb
    if tp > T:
        q = jnp.pad(q, ((0, 0), (0, tp - T), (0, 0), (0, 0)))
        kcat = jnp.pad(kcat, ((0, 0), (0, tp - T), (0, 0), (0, 0)))
        vcat = jnp.pad(vcat, ((0, 0), (0, tp - T), (0, 0), (0, 0)))
    kw = WINDOW + qb
    idx = jnp.arange(nb)[:, None] * qb + jnp.arange(kw)[None, :]
    kb = kcat[:, idx]
    vb = vcat[:, idx]
    qr = q.reshape(B, nb, qb, SWA_KV, G, SWA_HD)
    s = jnp.einsum('bnqkgd,bnskd->bnkgqs', qr, kb).astype(jnp.float32) * (SWA_HD ** -0.5)
    qpos = start + jnp.arange(tp).reshape(nb, qb)
    kpos = start - WINDOW + idx
    dist = qpos[:, :, None] - kpos[:, None, :]
    valid = (dist >= 0) & (dist <= WINDOW) & (kpos[:, None, :] >= 0)
    bias = -slopes.reshape(SWA_KV, G)[None, :, :, None, None] * dist[:, None, None].astype(jnp.float32)
    s = jnp.where(valid[:, None, None], s + bias, -jnp.inf)
    sink = jnp.broadcast_to(sinks.astype(jnp.float32).reshape(1, 1, SWA_KV, G, 1, 1), s.shape[:-1] + (1,))
    p = jax.nn.softmax(jnp.concatenate([s, sink], axis=-1), axis=-1)[..., :-1]
    o = jnp.einsum('bnkgqs,bnskd->bnqkgd', p.astype(vb.dtype), vb)
    return o.reshape(B, tp, SWA_WIDTH)[:, :T], new_k_buf, new_v_buf


def memory_attention(q, mk, mv):
    B, T = q.shape[0], q.shape[1]
    s = jnp.einsum('bthd,bmhd->bhtm', q, mk.astype(q.dtype)).astype(jnp.float32) * (MEM_HD ** -0.5)
    p = jax.nn.softmax(s, axis=-1).astype(q.dtype)
    return jnp.einsum('bhtm,bmhd->bthd', p, mv.astype(q.dtype)).reshape(B, T, MEM_WIDTH)


def layer_forward(x, start, swa_pk, swa_pv, mem_k, mem_v, conv_prefix, slopes,
                  norm_mix_g, w_in, gmlp_norm_g, gmlp_ws, gmlp_bs, attn_sinks,
                  w_br_g, w_br_a, w_br_m, w_out, norm_ffn_g, w_up, conv_w, conv_b, w_down):
    B, T, _ = x.shape
    xn = rmsnorm(x, norm_mix_g)
    z = xn @ w_in
    c1 = G_WIDTH
    c2 = c1 + G_WIDTH
    c3 = c2 + SWA_WIDTH
    c4 = c3 + SWA_KV_WIDTH
    c5 = c4 + SWA_KV_WIDTH
    c6 = c5 + MEM_WIDTH
    zu, zv, zq, zk, zvv, zm, zg = jnp.split(z, [c1, c2, c3, c4, c5, c6], axis=-1)
    u = jax.nn.gelu(zu)
    vg = rmsnorm(jax.nn.gelu(zv), gmlp_norm_g)
    o_g = u * gmlp_spatial(vg, gmlp_ws, gmlp_bs)
    c0 = ((start + T - 1) // CHUNK) * CHUNK - start
    v_rows = vg[:, c0:]
    q = zq.reshape(B, T, SWA_HEADS, SWA_HD)
    k = zk.reshape(B, T, SWA_KV, SWA_HD)
    v = zvv.reshape(B, T, SWA_KV, SWA_HD)
    o_a, kbuf, vbuf = swa_attention(q, k, v, swa_pk, swa_pv, start, attn_sinks, slopes)
    o_m = memory_attention(zm.reshape(B, T, MEM_HEADS, MEM_HD), mem_k, mem_v)
    gates = jax.nn.sigmoid(zg.astype(jnp.float32)).astype(x.dtype).reshape(B, T, N_BRANCH, D_MODEL)
    merged = (gates[:, :, 0] * (o_g @ w_br_g) + gates[:, :, 1] * (o_a @ w_br_a)
              + gates[:, :, 2] * (o_m @ w_br_m))
    x = x + merged @ w_out
    h = rmsnorm(x, norm_ffn_g) @ w_up
    hc = jnp.concatenate([conv_prefix.astype(h.dtype), h], axis=1)
    hconv = conv_b
    for j in range(CONV_W):
        hconv = hconv + hc[:, j:j + T] * conv_w[j]
    a, b = jnp.split(hconv, 2, axis=-1)
    x = x + (jax.nn.gelu(a) * b) @ w_down
    conv_buf = hc[:, -(CONV_W - 1):]
    return x, kbuf, vbuf, v_rows, conv_buf


def setup_inputs(seed: int = 0) -> dict:
    key = jax.random.key(seed)
    ks = jax.random.split(key, 32)

    def nrm(k, shape, scale):
        return jax.random.normal(k, shape, jnp.float32) * scale

    win_buf = min(WINDOW, PAST_LEN)
    return {
        'x_prompt': nrm(ks[0], (BATCH, SEQ, D_MODEL), 1.0),
        'x_sample': nrm(ks[1], (DEC_BATCH, DEC_SEQ, D_MODEL), 1.0),
        'cache_swa_k': nrm(ks[2], (DEPTH, DEC_BATCH, win_buf, SWA_KV, SWA_HD), 1.0),
        'cache_swa_v': nrm(ks[3], (DEPTH, DEC_BATCH, win_buf, SWA_KV, SWA_HD), 1.0),
        'cache_mem_k': nrm(ks[4], (DEPTH, DEC_BATCH, MEM_LEN, MEM_HEADS, MEM_HD), 1.0),
        'cache_mem_v': nrm(ks[5], (DEPTH, DEC_BATCH, MEM_LEN, MEM_HEADS, MEM_HD), 1.0),
        'state_conv': nrm(ks[6], (DEPTH, DEC_BATCH, CONV_W - 1, 2 * D_FF), 1.0),
        'mem_prompt': nrm(ks[7], (BATCH, MEM_LEN, D_MODEL), 1.0),
        'norm_mix_g': 1.0 + nrm(ks[8], (DEPTH, D_MODEL), 0.02),
        'w_in': nrm(ks[9], (DEPTH, D_MODEL, N_IN), D_MODEL ** -0.5),
        'gmlp_norm_g': 1.0 + nrm(ks[10], (DEPTH, G_WIDTH), 0.02),
        'gmlp_ws': nrm(ks[11], (DEPTH, G_GROUPS, CHUNK, CHUNK), 0.5 * CHUNK ** -0.5),
        'gmlp_bs': 1.0 + nrm(ks[12], (DEPTH, G_GROUPS, CHUNK), 0.02),
        'attn_sinks': nrm(ks[13], (DEPTH, SWA_HEADS), 0.5),
        'mem_norm_g': 1.0 + nrm(ks[14], (DEPTH, D_MODEL), 0.02),
        'w_mem_kv': nrm(ks[15], (DEPTH, D_MODEL, 2 * MEM_WIDTH), D_MODEL ** -0.5),
        'w_br_g': nrm(ks[16], (DEPTH, G_WIDTH, D_MODEL), G_WIDTH ** -0.5),
        'w_br_a': nrm(ks[17], (DEPTH, SWA_WIDTH, D_MODEL), SWA_WIDTH ** -0.5),
        'w_br_m': nrm(ks[18], (DEPTH, MEM_WIDTH, D_MODEL), MEM_WIDTH ** -0.5),
        'w_out': nrm(ks[19], (DEPTH, D_MODEL, D_MODEL), D_MODEL ** -0.5),
        'norm_ffn_g': 1.0 + nrm(ks[20], (DEPTH, D_MODEL), 0.02),
        'w_up': nrm(ks[21], (DEPTH, D_MODEL, 2 * D_FF), D_MODEL ** -0.5),
        'conv_w': nrm(ks[22], (DEPTH, CONV_W, 2 * D_FF), CONV_W ** -0.5),
        'conv_b': nrm(ks[23], (DEPTH, 2 * D_FF), 0.02),
        'w_down': nrm(ks[24], (DEPTH, D_FF, D_MODEL), D_FF ** -0.5),
        'final_norm_g': 1.0 + nrm(ks[25], (D_MODEL,), 0.02),
    }


def reference(x_prompt, x_sample, cache_swa_k, cache_swa_v, cache_mem_k, cache_mem_v, state_conv,
              mem_prompt, norm_mix_g, w_in, gmlp_norm_g, gmlp_ws, gmlp_bs, attn_sinks, mem_norm_g,
              w_mem_kv, w_br_g, w_br_a, w_br_m, w_out, norm_ffn_g, w_up, conv_w, conv_b, w_down,
              final_norm_g):
    slopes = alibi_slopes(SWA_HEADS)
    xp = x_prompt
    xs = x_sample
    Bp = xp.shape[0]
    pk, pv, sk, sv, mkp, mvp, gvp, gvs, cvp, cvs = ([] for _ in range(10))
    zero_kv = jnp.zeros((Bp, 0, SWA_KV, SWA_HD), xp.dtype)
    zero_conv = jnp.zeros((Bp, CONV_W - 1, 2 * D_FF), xp.dtype)
    for l in range(DEPTH):
        lw = dict(norm_mix_g=norm_mix_g[l], w_in=w_in[l], gmlp_norm_g=gmlp_norm_g[l],
                  gmlp_ws=gmlp_ws[l], gmlp_bs=gmlp_bs[l], attn_sinks=attn_sinks[l],
                  w_br_g=w_br_g[l], w_br_a=w_br_a[l], w_br_m=w_br_m[l], w_out=w_out[l],
                  norm_ffn_g=norm_ffn_g[l], w_up=w_up[l], conv_w=conv_w[l], conv_b=conv_b[l],
                  w_down=w_down[l])
        mkv = rmsnorm(mem_prompt, mem_norm_g[l]) @ w_mem_kv[l]
        mk = mkv[..., :MEM_WIDTH].reshape(Bp, MEM_LEN, MEM_HEADS, MEM_HD)
        mv = mkv[..., MEM_WIDTH:].reshape(Bp, MEM_LEN, MEM_HEADS, MEM_HD)
        xp, kb, vb, gv, cb = layer_forward(xp, 0, zero_kv, zero_kv, mk, mv, zero_conv, slopes, **lw)
        pk.append(kb); pv.append(vb); mkp.append(mk); mvp.append(mv); gvp.append(gv); cvp.append(cb)
        xs, kb, vb, gv, cb = layer_forward(xs, PAST_LEN, cache_swa_k[l], cache_swa_v[l], cache_mem_k[l],
                                           cache_mem_v[l], state_conv[l], slopes, **lw)
        sk.append(kb); sv.append(vb); gvs.append(gv); cvs.append(cb)
    y_prompt = rmsnorm(xp, final_norm_g)
    y_sample = rmsnorm(xs, final_norm_g)
    return (y_prompt, y_sample, jnp.stack(pk), jnp.stack(pv), jnp.stack(sk), jnp.stack(sv),
            jnp.stack(mkp), jnp.stack(mvp), jnp.stack(gvp), jnp.stack(gvs), jnp.stack(cvp), jnp.stack(cvs))
```

```cpp
#include <hip/hip_runtime.h>
#include <hip/hip_cooperative_groups.h>
#include <cstdio>
namespace cg = cooperative_groups;

#define LAS __attribute__((address_space(3)))
typedef unsigned short bf16_t;
typedef short bf16x8 __attribute__((ext_vector_type(8)));
typedef short bf16x4 __attribute__((ext_vector_type(4)));
typedef float f32x4 __attribute__((ext_vector_type(4)));
typedef unsigned u32x4 __attribute__((ext_vector_type(4)));
typedef unsigned u32x2 __attribute__((ext_vector_type(2)));

constexpr int DM = 2048, TPR = 8192, MV = 8320, MP = 8448, DFF = 5632, DFF2 = 11264;
constexpr float EPSF = 1e-6f;
constexpr size_t oWIN = 0, oWMEM = 19398656, oWBG = 21495808, oWBA = 23068672, oWBM = 24641536, oWOUT = 26214400, oWUP = 30408704, oWDN = 53477376, LW = 65011712;
constexpr size_t WS_W = 0;
constexpr size_t WS_X = WS_W + 2 * LW * 2;
constexpr size_t WS_XB = WS_X + (size_t)MP * DM * 4;
constexpr size_t WS_MG = WS_XB + (size_t)MP * DM * 2;
constexpr size_t WS_ACT = WS_MG + (size_t)MP * DM * 2;
constexpr size_t WS_MEMN = WS_ACT + (size_t)MP * DFF * 2;
constexpr size_t WS_MKV = WS_MEMN + (size_t)2 * 1024 * 2048 * 2;
constexpr size_t WS_RS = WS_MKV + (size_t)1024 * 1024 * 2;
constexpr size_t WS_PSV = WS_RS + (size_t)MP * 32 * 4;
constexpr size_t WS_R1 = WS_PSV + (size_t)MP * 16 * 4;
constexpr size_t R_GT = 0;
constexpr size_t R_U = R_GT + (size_t)MP * 6144 * 2;
constexpr size_t R_GV = R_U + (size_t)MP * 768 * 2;
constexpr size_t R_Q = R_GV + (size_t)MP * 768 * 4;
constexpr size_t R_KB = R_Q + (size_t)MP * 768 * 2;
constexpr size_t R_VB = R_KB + (size_t)MP * 256 * 2;
constexpr size_t R_MQ = R_VB + (size_t)MP * 256 * 2;
constexpr size_t R_OG = R_MQ + (size_t)MP * 512 * 2;
constexpr size_t R_OA = R_OG + (size_t)MP * 768 * 2;
constexpr size_t R_OM = R_OA + (size_t)MP * 768 * 2;
constexpr size_t R_END = R_OM + (size_t)MP * 768 * 2;
constexpr size_t R_H = 0;
constexpr size_t WS_BAR = WS_R1 + R_END;
constexpr size_t WS_PART = WS_BAR + 4096;
constexpr size_t WS_END = WS_PART + (size_t)4 * 22 * 8 * 128 * 256 * 4;
constexpr size_t O_Y = 0, O_KP = 17039360, O_VP = 17301504, O_KS = 17563648, O_VS = 25952256, O_MK = 34340864, O_MV = 35389440,
                 O_GVP = 36438016, O_GVS = 37224448, O_CP = 37421056, O_CS = 37601280;
constexpr int LDS_BYTES = 140 * 1024;

struct Params { const float* in[26]; float* out; unsigned char* ws; int ph_lo, ph_hi; };

typedef float f32x2_t __attribute__((ext_vector_type(2)));
typedef __bf16 bf16v2_t __attribute__((ext_vector_type(2)));
__device__ __forceinline__ unsigned cvt_pk_bf16(float lo, float hi) { const f32x2_t f = {lo, hi}; const bf16v2_t b = __builtin_convertvector(f, bf16v2_t); return __builtin_bit_cast(unsigned, b); }
__device__ __forceinline__ float bf2f(unsigned short b) { return __uint_as_float(((unsigned)b) << 16); }
__device__ __forceinline__ float bflo(unsigned u) { return __uint_as_float(u << 16); }
__device__ __forceinline__ float bfhi(unsigned u) { return __uint_as_float(u & 0xffff0000u); }
__device__ __forceinline__ float gelu_t(float x) { const float u = 1.5957691216f * (x + 0.044715f * x * x * x); return x * __builtin_amdgcn_rcpf(1.0f + __expf(-u)); }
__device__ __forceinline__ float sigmoid_f(float z) { return __builtin_amdgcn_rcpf(1.0f + __expf(-z)); }
__device__ __forceinline__ u32x2 pack4(f32x4 v) { u32x2 r; r.x = cvt_pk_bf16(v[0], v[1]); r.y = cvt_pk_bf16(v[2], v[3]); return r; }
__device__ __forceinline__ float slope_of(int h) { return h < 8 ? exp2f(-(float)(h + 1)) : exp2f(-((float)(h - 8) + 0.5f)); }

__device__ __forceinline__ int otid() { int t = threadIdx.x; asm volatile("" : "+v"(t)); return t; }

__device__ __forceinline__ u32x2 ld8c(const void* p) { const unsigned long long v = __hip_atomic_load((const unsigned long long*)p, __ATOMIC_RELAXED, __HIP_MEMORY_SCOPE_AGENT); u32x2 r; r.x = (unsigned)v; r.y = (unsigned)(v >> 32); return r; }
__device__ __forceinline__ u32x4 ld16_sc1(const void* p) { u32x4 v; asm volatile("global_load_dwordx4 %0, %1, off sc0 sc1\n\ts_waitcnt vmcnt(0)" : "=v"(v) : "v"(p) : "memory"); return v; }
__device__ __forceinline__ f32x4 ldf4_sc1(const void* p) { f32x4 v; asm volatile("global_load_dwordx4 %0, %1, off sc0 sc1\n\ts_waitcnt vmcnt(0)" : "=v"(v) : "v"(p) : "memory"); return v; }
__device__ __forceinline__ float rowsum32(const float* ps, int row) { const f32x4* q = (const f32x4*)(ps + (size_t)row * 32); f32x4 a = q[0];
#pragma unroll
    for (int i = 1; i < 8; ++i) a += q[i];
    return (a[0] + a[1]) + (a[2] + a[3]); }
__device__ __forceinline__ float rowsum16(const float* ps, int row) { const f32x4* q = (const f32x4*)(ps + (size_t)row * 16); f32x4 a = (q[0] + q[1]) + (q[2] + q[3]); return (a[0] + a[1]) + (a[2] + a[3]); }

namespace pg8 {
constexpr int BM = 256, BK = 64, HALF = 128, HTB = HALF * BK * 2, STAGE_BYTES = 8 * HTB, NXCD = 8, WGM = 8;
__device__ __forceinline__ int lds_byte(int r, int c) { const int st = (r >> 4) * 2 + (c >> 5), rr = r & 15, cc = c & 31, ob = rr * 64 + cc * 2; return st * 1024 + (ob ^ (((ob >> 9) & 1) << 5)); }
__device__ __forceinline__ void stage_rc(int b, int& R, int& C) { const int st = b / 1024, sb = b % 1024, swz = sb ^ (((sb >> 9) & 1) << 5); R = (st >> 1) * 16 + swz / 64; C = (st & 1) * 32 + (swz % 64) / 2; }
struct Unit { int pm, pn, seg; };
struct Gemm { const bf16_t *A0, *A1, *A2, *B0, *B1, *B2; int K; };
struct Sched {
    int nM, nN, nwg, G, c, nseg, extra, extraN, split;
    __device__ void init(int nM_, int nN_, int G_, int c_, int nseg_, int extra_, int extraN_, int split_ = 0) { nM = nM_; nN = nN_; nwg = nM * nN; G = G_; c = c_; nseg = nseg_; extra = extra_; extraN = extraN_; split = split_; }
    __device__ __forceinline__ bool next(int i, Unit& u) const {
        int ti = i, seg = 0;
        if (nseg == 3) { ti = i / 3; seg = i - ti * 3; }
        const long L = (long)ti * G + c;
        const bool ok = L < (long)(nwg + extra);
        const bool ex = L >= (long)nwg;
        const int e = (int)L - nwg;
        int wgid = ex ? 0 : (int)L; { const int q = nwg / NXCD, r = nwg % NXCD, xcd = wgid % NXCD, off = wgid / NXCD; wgid = (xcd < r ? xcd * (q + 1) : r * (q + 1) + (xcd - r) * q) + off; }
        const int nig = WGM * nN, gid = wgid / nig, fm = gid * WGM, gsz = (nM - fm) < WGM ? (nM - fm) : WGM;
        const int pm0 = fm + ((wgid % nig) % gsz), pn0 = (wgid % nig) / gsz;
        Unit r; r.pm = ex ? e / extraN : pm0; r.pn = ex ? e % extraN : pn0; r.seg = ex ? 1 : seg;
        if (split && ex) { r.pm = 32; r.seg = 1 + e / extraN; }
        if (!ok) { r.pm = 0; r.pn = 0; r.seg = 0; }
        u = r; return ok;
    }
};

template <class Epi>
__device__ __forceinline__ void gemm_phase(LAS unsigned char* lds, const Gemm g, const Sched& S, const Epi& E) {
    const int tid = otid(), wid = __builtin_amdgcn_readfirstlane(tid >> 6), lane = tid & 63, wr = wid >> 2, wc = wid & 3, fr = lane & 15, fq = lane >> 4;
    const int K = g.K, nt = K / BK;
    const char* const gA0 = (const char*)g.A0; const char* const gA1 = (const char*)g.A1; const char* const gA2 = (const char*)g.A2;
    const char* const gB0 = (const char*)g.B0; const char* const gB1 = (const char*)g.B1; const char* const gB2 = (const char*)g.B2;
#define GA(s) ((s) == 0 ? gA0 : ((s) == 1 ? gA1 : gA2))
#define GB(s) ((s) == 0 ? gB0 : ((s) == 1 ? gB1 : gB2))
    unsigned voffA[2];
#pragma unroll
    for (int i = 0; i < 2; ++i) { int R, C; stage_rc(tid * 16 + i * 8192, R, C); voffA[i] = (unsigned)(R * K + C) * 2u; }
    const size_t kstep = (size_t)(BK * 2);
    const size_t hstep = (size_t)HALF * K * 2;
    const size_t tstep = 2 * hstep;
    const unsigned ldsw = (unsigned)wid * 1024u;
    const int aoff = lds_byte(wr * 64 + fr, fq * 8), boff = lds_byte(wc * 32 + fr, fq * 8);
#define PG8_SA(b, h) (((b) * 2 + (h)) * HTB)
#define PG8_SB(b, h) ((4 + (b) * 2 + (h)) * HTB)
#define PG8_STAGE(bufoff, gbase, voff) do { _Pragma("unroll") for (int _i = 0; _i < 2; ++_i) \
        __builtin_amdgcn_global_load_lds((const unsigned*)((const char*)(gbase) + (voff)[_i]), (LAS unsigned*)(lds + (bufoff) + ldsw + _i * 8192), 16, 0, 0); } while (0)
#define PG8_LDA(dst, b, h) do { _Pragma("unroll") for (int m = 0; m < 4; ++m) _Pragma("unroll") for (int k = 0; k < 2; ++k) dst[m][k] = *(const LAS bf16x8*)(lds + PG8_SA(b, h) + aoff + m * 2048 + k * 1024); } while (0)
#define PG8_LDB(dst, b, h) do { _Pragma("unroll") for (int n = 0; n < 2; ++n) _Pragma("unroll") for (int k = 0; k < 2; ++k) dst[n][k] = *(const LAS bf16x8*)(lds + PG8_SB(b, h) + boff + n * 2048 + k * 1024); } while (0)
#define PG8_MMA(ai, bj, At, Bt) do { __builtin_amdgcn_s_setprio(1); _Pragma("unroll") for (int m = 0; m < 4; ++m) _Pragma("unroll") for (int n = 0; n < 2; ++n) _Pragma("unroll") for (int k = 0; k < 2; ++k) \
        acc[ai][bj][m][n] = __builtin_amdgcn_mfma_f32_16x16x32_bf16(Bt[n][k], At[m][k], acc[ai][bj][m][n], 0, 0, 0); __builtin_amdgcn_s_setprio(0); } while (0)
#define PG8_WAIT_V(n) asm volatile("s_waitcnt vmcnt(" #n ")" ::: "memory")
#define PG8_WAIT_L(n) asm volatile("s_waitcnt lgkmcnt(" #n ")" ::: "memory")
#define PG8_BAR __builtin_amdgcn_s_barrier()
#define PG8_SCHED __builtin_amdgcn_sched_barrier(0)
    Unit cur, nxt; int ui = 0;
    if (!S.next(0, cur)) return;
    f32x4 acc[2][2][4][2];
#pragma unroll
    for (int a = 0; a < 2; ++a)
#pragma unroll
        for (int b = 0; b < 2; ++b)
#pragma unroll
            for (int m = 0; m < 4; ++m)
#pragma unroll
                for (int n = 0; n < 2; ++n) acc[a][b][m][n] = (f32x4){0.f, 0.f, 0.f, 0.f};
    bf16x8 At[4][2], B0[2][2], B1[2][2];
#define UK0(u) ((S.split && (u).seg > 0) ? (size_t)((u).seg - 1) * S.split * kstep : (size_t)0)
    const char* cA = GA(cur.seg) + (size_t)cur.pm * tstep + UK0(cur); const char* cB = GB(cur.seg) + (size_t)cur.pn * tstep + UK0(cur);
    PG8_STAGE(PG8_SB(0, 0), cB, voffA); PG8_STAGE(PG8_SA(0, 0), cA, voffA); PG8_STAGE(PG8_SB(0, 1), cB + hstep, voffA); PG8_STAGE(PG8_SA(0, 1), cA + hstep, voffA);
    if (wr == 1) PG8_BAR;
    PG8_WAIT_V(4); PG8_BAR;
    PG8_STAGE(PG8_SB(1, 0), cB + kstep, voffA); PG8_STAGE(PG8_SA(1, 0), cA + kstep, voffA); PG8_STAGE(PG8_SB(1, 1), cB + hstep + kstep, voffA);
    PG8_WAIT_V(6); PG8_BAR;
    for (;;) {
        const bool has_next = S.next(ui + 1, nxt);
        const char* nA = has_next ? GA(nxt.seg) + (size_t)nxt.pm * tstep + UK0(nxt) : cA; const char* nB = has_next ? GB(nxt.seg) + (size_t)nxt.pn * tstep + UK0(nxt) : cB;
        const int ntu = (S.split && cur.seg > 0) ? S.split : nt;
        for (int t = 0; t < ntu; t += 2) {
            const bool last = (t == ntu - 2);
            const char* a1 = cA + (size_t)(t + 1) * kstep;
            const char* a2 = last ? nA : cA + (size_t)(t + 2) * kstep; const char* b2 = last ? nB : cB + (size_t)(t + 2) * kstep;
            const char* a3 = a2 + kstep; const char* b3 = b2 + kstep;
            PG8_LDB(B0, 0, 0); PG8_SCHED; PG8_LDA(At, 0, 0); PG8_STAGE(PG8_SA(1, 1), a1 + hstep, voffA);
            PG8_WAIT_L(8); PG8_BAR; PG8_WAIT_L(0); PG8_MMA(0, 0, At, B0); PG8_BAR; PG8_SCHED;
            PG8_LDB(B1, 0, 1); PG8_STAGE(PG8_SB(0, 0), b2, voffA);
            PG8_BAR; PG8_WAIT_L(0); PG8_MMA(0, 1, At, B1); PG8_BAR;
            PG8_LDA(At, 0, 1); PG8_STAGE(PG8_SA(0, 0), a2, voffA);
            PG8_BAR; PG8_WAIT_L(0); PG8_MMA(1, 0, At, B0); PG8_BAR; PG8_SCHED;
            PG8_STAGE(PG8_SB(0, 1), b2 + hstep, voffA);
            PG8_WAIT_V(6); PG8_BAR; PG8_MMA(1, 1, At, B1); PG8_BAR;
            PG8_LDB(B0, 1, 0); PG8_SCHED; PG8_LDA(At, 1, 0); PG8_STAGE(PG8_SA(0, 1), a2 + hstep, voffA);
            PG8_WAIT_L(8); PG8_BAR; PG8_WAIT_L(0); PG8_MMA(0, 0, At, B0); PG8_BAR; PG8_SCHED;
            PG8_LDB(B1, 1, 1); PG8_STAGE(PG8_SB(1, 0), b3, voffA);
            PG8_BAR; PG8_WAIT_L(0); PG8_MMA(0, 1, At, B1); PG8_BAR;
            PG8_LDA(At, 1, 1); PG8_STAGE(PG8_SA(1, 0), a3, voffA);
            PG8_BAR; PG8_WAIT_L(0); PG8_MMA(1, 0, At, B0); PG8_BAR; PG8_SCHED;
            PG8_STAGE(PG8_SB(1, 1), b3 + hstep, voffA);
            PG8_WAIT_V(6); PG8_BAR; PG8_MMA(1, 1, At, B1); PG8_BAR;
        }
        const bool keep = E(acc, cur, wr, wc, fr, fq, ui);
        if (!has_next) break;
        if (!keep) {
#pragma unroll
            for (int a = 0; a < 2; ++a)
#pragma unroll
                for (int b = 0; b < 2; ++b)
#pragma unroll
                    for (int m = 0; m < 4; ++m)
#pragma unroll
                        for (int n = 0; n < 2; ++n) acc[a][b][m][n] = (f32x4){0.f, 0.f, 0.f, 0.f};
        }
        cur = nxt; cA = nA; cB = nB; ++ui;
    }
    PG8_WAIT_V(0);
    if (wr == 0) PG8_BAR;
    PG8_BAR;
#undef GA
#undef GB
#undef UK0
#undef PG8_SA
#undef PG8_SB
#undef PG8_STAGE
#undef PG8_LDA
#undef PG8_LDB
#undef PG8_MMA
#undef PG8_WAIT_V
#undef PG8_WAIT_L
#undef PG8_BAR
#undef PG8_SCHED
}

template <class Epi>
__device__ __forceinline__ void gemm_simple(const Gemm g, const Sched& S, const Epi& E) {
    const int tid = otid(), wid = tid >> 6, lane = tid & 63, wr = wid >> 2, wc = wid & 3, fr = lane & 15, fq = lane >> 4;
    const int K = g.K;
    Unit cur; int ui = 0;
    f32x4 acc[2][2][4][2];
    bool keep = false;
    while (S.next(ui, cur)) {
        if (!keep) {
#pragma unroll
            for (int a = 0; a < 2; ++a)
#pragma unroll
                for (int b = 0; b < 2; ++b)
#pragma unroll
                    for (int m = 0; m < 4; ++m)
#pragma unroll
                        for (int n = 0; n < 2; ++n) acc[a][b][m][n] = (f32x4){0.f, 0.f, 0.f, 0.f};
        }
        const bf16_t* A = cur.seg == 0 ? g.A0 : (cur.seg == 1 ? g.A1 : g.A2); const bf16_t* B = cur.seg == 0 ? g.B0 : (cur.seg == 1 ? g.B1 : g.B2);
        const bf16_t* ap = A + (size_t)(cur.pm * 256 + wr * 64 + fr) * K + fq * 8;
        const bf16_t* bp = B + (size_t)(cur.pn * 256 + wc * 32 + fr) * K + fq * 8;
        for (int k0 = 0; k0 < K; k0 += 32) {
            bf16x8 af[2][4], bfr[2][2];
#pragma unroll
            for (int ai = 0; ai < 2; ++ai)
#pragma unroll
                for (int m = 0; m < 4; ++m) { union { u32x4 u; bf16x8 b; } t; t.u = ld16_sc1(ap + (size_t)(ai * 128 + m * 16) * K + k0); af[ai][m] = t.b; }
#pragma unroll
            for (int bj = 0; bj < 2; ++bj)
#pragma unroll
                for (int n = 0; n < 2; ++n) { union { u32x4 u; bf16x8 b; } t; t.u = ld16_sc1(bp + (size_t)(bj * 128 + n * 16) * K + k0); bfr[bj][n] = t.b; }
#pragma unroll
            for (int ai = 0; ai < 2; ++ai)
#pragma unroll
                for (int bj = 0; bj < 2; ++bj)
#pragma unroll
                    for (int m = 0; m < 4; ++m)
#pragma unroll
                        for (int n = 0; n < 2; ++n) acc[ai][bj][m][n] = __builtin_amdgcn_mfma_f32_16x16x32_bf16(bfr[bj][n], af[ai][m], acc[ai][bj][m][n], 0, 0, 0);
        }
        keep = E(acc, cur, wr, wc, fr, fq, ui);
        ++ui;
    }
}
}
using pg8::Unit;

#define EPI_ROWLOOP for (int ai = 0; ai < 2; ++ai) for (int m = 0; m < 4; ++m)
#define EPI_COLLOOP for (int bj = 0; bj < 2; ++bj) for (int n = 0; n < 2; ++n)

__device__ __forceinline__ void row_scales(const float* ps, int row0, int fq, float (&rr)[2][4]) {
#pragma unroll
    for (int ai = 0; ai < 2; ++ai) {
        f32x4 a[4], b[4];
#pragma unroll
        for (int m = 0; m < 4; ++m) { int row = row0 + ai * 128 + m * 16; row = row < MV ? row : MV - 1; const f32x4* q = (const f32x4*)(ps + (size_t)row * 32 + fq * 8); a[m] = q[0]; b[m] = q[1]; }
#pragma unroll
        for (int m = 0; m < 4; ++m) { const f32x4 t = a[m] + b[m]; float sm = (t[0] + t[1]) + (t[2] + t[3]); sm += __shfl_xor(sm, 16); sm += __shfl_xor(sm, 32); rr[ai][m] = rsqrtf(sm * (1.0f / 2048.0f) + EPSF); }
    }
}

struct EpiB {
    int l; const float* rsx; float* rsv; float* out; const LAS float* rsl;
    bf16_t *U, *Q, *KB, *VB, *MQ, *GT, *MKV; float* GV;
    __device__ __forceinline__ bool operator()(f32x4 (&acc)[2][2][4][2], const Unit& u, int wr, int wc, int fr, int fq, int ui) const {
        const int row0 = u.pm * 256 + wr * 64 + fr, cb = wc * 32 + 4 * fq;
        if (u.seg == 1) {
#pragma unroll
            EPI_ROWLOOP { const int row = row0 + ai * 128 + m * 16;
#pragma unroll
                EPI_COLLOOP { const int col = u.pn * 256 + bj * 128 + n * 16 + cb; const f32x4 v = acc[ai][bj][m][n];
                    float* o = out + (col < 512 ? O_MK : O_MV) + (size_t)l * (4 * 256 * 512) + (size_t)row * 512 + (col & 511);
                    *(f32x4*)o = v; *(u32x2*)(MKV + (size_t)row * 1024 + col) = pack4(v); } }
            return false;
        }
        float rr[2][4];
        if (ui < 6) {
#pragma unroll
            EPI_ROWLOOP rr[ai][m] = rsl[ui * 256 + ai * 128 + wr * 64 + m * 16 + fr];
        } else row_scales(rsx, row0, fq, rr);
        const int pn = u.pn;
        if (pn < 3) {
#pragma unroll
            EPI_ROWLOOP { const int row = row0 + ai * 128 + m * 16; if (row < MV) {
#pragma unroll
                EPI_COLLOOP { const int col = pn * 256 + bj * 128 + n * 16 + cb; f32x4 v = acc[ai][bj][m][n] * rr[ai][m];
                    v[0] = gelu_t(v[0]); v[1] = gelu_t(v[1]); v[2] = gelu_t(v[2]); v[3] = gelu_t(v[3]);
                    *(u32x2*)(U + (size_t)row * 768 + col) = pack4(v); } } }
        } else if (pn < 6) {
#pragma unroll
            EPI_ROWLOOP { const int row = row0 + ai * 128 + m * 16; float ss = 0.f;
#pragma unroll
                EPI_COLLOOP { const int col = (pn - 3) * 256 + bj * 128 + n * 16 + cb; f32x4 v = acc[ai][bj][m][n] * rr[ai][m];
                    v[0] = gelu_t(v[0]); v[1] = gelu_t(v[1]); v[2] = gelu_t(v[2]); v[3] = gelu_t(v[3]);
                    ss += v[0] * v[0] + v[1] * v[1] + v[2] * v[2] + v[3] * v[3];
                    if (row < MV) *(f32x4*)(GV + (size_t)row * 768 + col) = v; }
                ss += __shfl_xor(ss, 16); ss += __shfl_xor(ss, 32);
                if (fq == 0 && row < MV) rsv[(size_t)row * 16 + (pn - 3) * 4 + wc] = ss; }
        } else if (pn < 9) {
#pragma unroll
            EPI_ROWLOOP { const int row = row0 + ai * 128 + m * 16; if (row < MV) { const float sc = rr[ai][m] * 0.125f;
#pragma unroll
                EPI_COLLOOP { const int col = (pn - 6) * 256 + bj * 128 + n * 16 + cb;
                    *(u32x2*)(Q + (size_t)row * 768 + col) = pack4(acc[ai][bj][m][n] * sc); } } }
        } else if (pn < 11) {
            bf16_t* dst = pn == 9 ? KB : VB; const size_t obp = pn == 9 ? O_KP : O_VP, obs = pn == 9 ? O_KS : O_VS;
#pragma unroll
            EPI_ROWLOOP { const int row = row0 + ai * 128 + m * 16; if (row < MV) {
                float* o = nullptr;
                if (row >= TPR) o = out + obs + ((size_t)(l * 128 + (row - TPR)) * 128 + 127) * 256;
                else if ((row & 2047) >= 1920) o = out + obp + ((size_t)(l * 4 + (row >> 11)) * 128 + ((row & 2047) - 1920)) * 256;
#pragma unroll
                EPI_COLLOOP { const int col = bj * 128 + n * 16 + cb; const f32x4 v = acc[ai][bj][m][n] * rr[ai][m];
                    *(u32x2*)(dst + (size_t)row * 256 + col) = pack4(v);
                    if (o) *(f32x4*)(o + col) = v; } } }
        } else if (pn < 13) {
#pragma unroll
            EPI_ROWLOOP { const int row = row0 + ai * 128 + m * 16; if (row < MV) { const float sc = rr[ai][m] * 0.08838834764831845f;
#pragma unroll
                EPI_COLLOOP { const int col = (pn - 11) * 256 + bj * 128 + n * 16 + cb;
                    *(u32x2*)(MQ + (size_t)row * 512 + col) = pack4(acc[ai][bj][m][n] * sc); } } }
        } else {
#pragma unroll
            EPI_ROWLOOP { const int row = row0 + ai * 128 + m * 16; if (row < MV) {
#pragma unroll
                EPI_COLLOOP { const int col = (pn - 13) * 256 + bj * 128 + n * 16 + cb; f32x4 v = acc[ai][bj][m][n] * rr[ai][m];
                    v[0] = sigmoid_f(v[0]); v[1] = sigmoid_f(v[1]); v[2] = sigmoid_f(v[2]); v[3] = sigmoid_f(v[3]);
#ifdef DIAG_SYNGT
                    v = (f32x4){0.25f + 0.001f * (float)(row & 255), 0.5f, 0.75f, 0.125f + 0.002f * (float)(col & 127)};
#endif
                    *(u32x2*)(GT + (size_t)row * 6144 + col) = pack4(v); } } }
        }
        return false;
    }
};

struct EpiD {
    const bf16_t* GT; bf16_t* MG;
    __device__ __forceinline__ bool operator()(f32x4 (&acc)[2][2][4][2], const Unit& u, int wr, int wc, int fr, int fq, int ui) const {
        const int row0 = u.pm * 256 + wr * 64 + fr, cb = u.pn * 256 + wc * 32 + 4 * fq; const int s = u.seg;
        const int s1 = s < 2 ? s + 1 : s;
#pragma unroll
        for (int ai = 0; ai < 2; ++ai) {
            u32x2 ga[4][2][2], gb[4][2][2];
#pragma unroll
            for (int m = 0; m < 4; ++m) { int row = row0 + ai * 128 + m * 16; row = row < MV ? row : MV - 1; const bf16_t* gp = GT + (size_t)row * 6144 + cb;
#pragma unroll
                EPI_COLLOOP { ga[m][bj][n] = *(const u32x2*)(gp + s * 2048 + bj * 128 + n * 16); gb[m][bj][n] = *(const u32x2*)(gp + s1 * 2048 + bj * 128 + n * 16); } }
#pragma unroll
            for (int m = 0; m < 4; ++m) { const int row = row0 + ai * 128 + m * 16;
#pragma unroll
                EPI_COLLOOP { const int col = bj * 128 + n * 16 + cb;
                    f32x4 g = {bflo(ga[m][bj][n].x), bfhi(ga[m][bj][n].x), bflo(ga[m][bj][n].y), bfhi(ga[m][bj][n].y)};
                    if (s < 2) { const u32x2 b2 = gb[m][bj][n];
                        g[0] *= __builtin_amdgcn_rcpf(bflo(b2.x)); g[1] *= __builtin_amdgcn_rcpf(bfhi(b2.x)); g[2] *= __builtin_amdgcn_rcpf(bflo(b2.y)); g[3] *= __builtin_amdgcn_rcpf(bfhi(b2.y));
                        acc[ai][bj][m][n] *= g;
                    } else if (row < MV) { *(u32x2*)(MG + (size_t)row * 2048 + col) = pack4(acc[ai][bj][m][n] * g); } } }
        }
        return s < 2;
    }
};

__device__ __forceinline__ void st8c(float* q, float a, float b) { const unsigned long long v = (unsigned long long)__float_as_uint(a) | ((unsigned long long)__float_as_uint(b) << 32); __hip_atomic_store((unsigned long long*)q, v, __ATOMIC_RELAXED, __HIP_MEMORY_SCOPE_AGENT); }
struct EpiR {
    const float* xs0; const float* xs1;
    bf16_t* XB; float* rs;
    float* part; unsigned* ctr; int nc;
    __device__ __forceinline__ f32x4 ldres(int row, int col) const {
        if (xs0) return *(const f32x4*)((row < TPR ? xs0 + (size_t)row * 2048 : xs1 + (size_t)(row - TPR) * 2048) + col);
        const u32x2 t = *(const u32x2*)(XB + (size_t)row * 2048 + col); return (f32x4){bflo(t.x), bfhi(t.x), bflo(t.y), bfhi(t.y)};
    }
    __device__ __forceinline__ bool operator()(f32x4 (&acc)[2][2][4][2], const Unit& u, int wr, int wc, int fr, int fq, int ui) const {
        const int row0 = u.pm * 256 + wr * 64 + fr, cb = u.pn * 256 + wc * 32 + 4 * fq;
        if (u.seg > 0) {
            float* pp = part + ((size_t)(u.seg - 1) * 8 + u.pn) * (128 * 256) + (size_t)(wr * 64 + fr) * 256 + wc * 32 + 4 * fq;
#pragma unroll
            for (int m = 0; m < 4; ++m)
#pragma unroll
                EPI_COLLOOP { const f32x4 v = acc[0][bj][m][n]; float* q = pp + (size_t)(m * 16) * 256 + bj * 128 + n * 16; st8c(q, v[0], v[1]); st8c(q + 2, v[2], v[3]); }
            asm volatile("s_waitcnt vmcnt(0)" ::: "memory");
            unsigned old = 0;
            if (fr == 0 && fq == 0) old = __hip_atomic_fetch_add(ctr + u.pn * 8 + wr * 4 + wc, 1u, __ATOMIC_RELAXED, __HIP_MEMORY_SCOPE_AGENT);
            old = (unsigned)__builtin_amdgcn_readfirstlane((int)old);
            if (old != (unsigned)(nc - 1)) return false;
            const float* pb = part + (size_t)u.pn * (128 * 256) + (size_t)(wr * 64 + fr) * 256 + wc * 32 + 4 * fq;
            f32x4 sum[4][2][2];
#pragma unroll
            for (int m = 0; m < 4; ++m)
#pragma unroll
                EPI_COLLOOP sum[m][bj][n] = ldres(row0 + m * 16, cb + bj * 128 + n * 16);
            for (int ch = 0; ch < nc; ++ch) { const float* q = pb + (size_t)ch * (8 * 128 * 256);
                u32x2 lo[4][2][2], hi[4][2][2];
#pragma unroll
                for (int m = 0; m < 4; ++m)
#pragma unroll
                    EPI_COLLOOP { lo[m][bj][n] = ld8c(q + (size_t)(m * 16) * 256 + bj * 128 + n * 16); hi[m][bj][n] = ld8c(q + (size_t)(m * 16) * 256 + bj * 128 + n * 16 + 2); }
#pragma unroll
                for (int m = 0; m < 4; ++m)
#pragma unroll
                    EPI_COLLOOP sum[m][bj][n] += (f32x4){__uint_as_float(lo[m][bj][n].x), __uint_as_float(lo[m][bj][n].y), __uint_as_float(hi[m][bj][n].x), __uint_as_float(hi[m][bj][n].y)}; }
#pragma unroll
            for (int m = 0; m < 4; ++m) { const int row = row0 + m * 16; float ss = 0.f;
#pragma unroll
                EPI_COLLOOP { const int col = bj * 128 + n * 16 + cb; const f32x4 v = sum[m][bj][n];
                    *(u32x2*)(XB + (size_t)row * 2048 + col) = pack4(v);
                    ss += v[0] * v[0] + v[1] * v[1] + v[2] * v[2] + v[3] * v[3]; }
                ss += __shfl_xor(ss, 16); ss += __shfl_xor(ss, 32);
                if (fq == 0) rs[(size_t)row * 32 + u.pn * 4 + wc] = ss; }
            return false;
        }
#pragma unroll
        for (int ai = 0; ai < 2; ++ai) {
            f32x4 xv[4][2][2];
#pragma unroll
            for (int m = 0; m < 4; ++m) { int row = row0 + ai * 128 + m * 16; row = row < MV ? row : MV - 1;
#pragma unroll
                EPI_COLLOOP xv[m][bj][n] = ldres(row, cb + bj * 128 + n * 16); }
#pragma unroll
            for (int m = 0; m < 4; ++m) { const int row = row0 + ai * 128 + m * 16; float ss = 0.f;
#pragma unroll
                EPI_COLLOOP { const int col = bj * 128 + n * 16 + cb; const f32x4 v = xv[m][bj][n] + acc[ai][bj][m][n];
                    if (row < MV) *(u32x2*)(XB + (size_t)row * 2048 + col) = pack4(v);
                    ss += v[0] * v[0] + v[1] * v[1] + v[2] * v[2] + v[3] * v[3]; }
                ss += __shfl_xor(ss, 16); ss += __shfl_xor(ss, 32);
                if (fq == 0 && row < MV) rs[(size_t)row * 32 + u.pn * 4 + wc] = ss; }
        }
        return false;
    }
};

struct EpiF {
    int l; const float* rsf; bf16_t* H; float* out; const LAS float* rsl;
    __device__ __forceinline__ bool operator()(f32x4 (&acc)[2][2][4][2], const Unit& u, int wr, int wc, int fr, int fq, int ui) const {
        const int row0 = u.pm * 256 + wr * 64 + fr, cb = u.pn * 256 + wc * 32 + 4 * fq;
        float rr[2][4];
        if (ui < 6) {
#pragma unroll
            EPI_ROWLOOP rr[ai][m] = rsl[ui * 256 + ai * 128 + wr * 64 + m * 16 + fr];
        } else row_scales(rsf, row0, fq, rr);
#pragma unroll
        EPI_ROWLOOP { const int row = row0 + ai * 128 + m * 16; if (row < MV) {
            const float r = rr[ai][m];
            float* o = nullptr;
            if (row >= TPR) o = out + O_CS + ((size_t)(l * 128 + (row - TPR)) * 2 + 1) * DFF2;
            else if ((row & 2047) >= 2046) o = out + O_CP + ((size_t)(l * 4 + (row >> 11)) * 2 + ((row & 2047) - 2046)) * DFF2;
#pragma unroll
            EPI_COLLOOP { const int col = bj * 128 + n * 16 + cb; const f32x4 v = acc[ai][bj][m][n] * r;
                *(u32x2*)(H + (size_t)row * DFF2 + col) = pack4(v);
                if (o) *(f32x4*)(o + col) = v; } } }
        return false;
    }
};

__device__ __forceinline__ bool wjob(const Params& p, int tile, const float*& W, int& N, bf16_t*& Wt, int& ldk, const float*& g, int& kt, int& nt) {
    if (tile >= 15744) return false;
    const int l = tile >= 7872 ? 1 : 0; int t = tile - l * 7872;
    bf16_t* wb = (bf16_t*)(p.ws + WS_W) + (size_t)l * LW; g = nullptr;
    int K, nN;
    if (t < 2368) { W = p.in[9] + (size_t)l * 2048 * 9472; K = 2048; N = 9472; Wt = wb + oWIN; g = p.in[8] + l * 2048; }
    else if (t < 2624) { t -= 2368; W = p.in[15] + (size_t)l * 2048 * 1024; K = 2048; N = 1024; Wt = wb + oWMEM; }
    else if (t < 2816) { t -= 2624; W = p.in[16] + (size_t)l * 768 * 2048; K = 768; N = 2048; Wt = wb + oWBG; }
    else if (t < 3008) { t -= 2816; W = p.in[17] + (size_t)l * 768 * 2048; K = 768; N = 2048; Wt = wb + oWBA; }
    else if (t < 3136) { t -= 3008; W = p.in[18] + (size_t)l * 512 * 2048; K = 768; N = 2048; Wt = wb + oWBM; }
    else if (t < 3648) { t -= 3136; W = p.in[19] + (size_t)l * 2048 * 2048; K = 2048; N = 2048; Wt = wb + oWOUT; }
    else if (t < 6464) { t -= 3648; W = p.in[21] + (size_t)l * 2048 * DFF2; K = 2048; N = DFF2; Wt = wb + oWUP; g = p.in[20] + l * 2048; }
    else { t -= 6464; W = p.in[24] + (size_t)l * DFF * 2048; K = DFF; N = 2048; Wt = wb + oWDN; }
    ldk = K; nN = N / 128; kt = t / nN; nt = t - kt * nN;
    return true;
}

__device__ __forceinline__ void convert_tiles(const Params& p, LAS unsigned char* lds, int first, int last, int stride) {
    const int tid = otid();
    LAS bf16_t* T = (LAS bf16_t*)lds;
    f32x4 cur[4], nxt[4]; float gs[4], gsn[4];
    {
        const float* W; int N, ldk, kt, nt; bf16_t* Wt; const float* g;
        if ((first < last && wjob(p, first, W, N, Wt, ldk, g, kt, nt))) {
#pragma unroll
            for (int i = 0; i < 4; ++i) { const int idx = tid + i * 512, kk = idx >> 5, n4 = (idx & 31) * 4;
                cur[i] = *(const f32x4*)(W + (size_t)(kt * 64 + kk) * N + nt * 128 + n4); gs[i] = g ? g[kt * 64 + kk] : 1.0f; }
        }
    }
    for (int tile = first; tile < last; tile += stride) {
        const float* W; int N, ldk, kt, nt; bf16_t* Wt; const float* g;
        {
            const float* W2; int N2, ldk2, kt2, nt2; bf16_t* Wt2; const float* g2;
            if (tile + stride < last && wjob(p, tile + stride, W2, N2, Wt2, ldk2, g2, kt2, nt2)) {
#pragma unroll
                for (int i = 0; i < 4; ++i) { const int idx = tid + i * 512, kk = idx >> 5, n4 = (idx & 31) * 4;
                    nxt[i] = *(const f32x4*)(W2 + (size_t)(kt2 * 64 + kk) * N2 + nt2 * 128 + n4); gsn[i] = g2 ? g2[kt2 * 64 + kk] : 1.0f; }
            }
        }
        wjob(p, tile, W, N, Wt, ldk, g, kt, nt);
        const int k0 = kt * 64, n0 = nt * 128;
#pragma unroll
        for (int i = 0; i < 4; ++i) { const int idx = tid + i * 512, kk = idx >> 5, n4 = (idx & 31) * 4;
            const f32x4 v = cur[i] * gs[i];
            const unsigned a = cvt_pk_bf16(v[0], v[1]), b = cvt_pk_bf16(v[2], v[3]);
            T[(n4 + 0) * 72 + kk] = (bf16_t)(a & 0xffff); T[(n4 + 1) * 72 + kk] = (bf16_t)(a >> 16);
            T[(n4 + 2) * 72 + kk] = (bf16_t)(b & 0xffff); T[(n4 + 3) * 72 + kk] = (bf16_t)(b >> 16); }
        __syncthreads();
#pragma unroll
        for (int i = 0; i < 2; ++i) { const int idx = tid + i * 512, n = idx >> 3, kc = (idx & 7) * 8;
            const u32x4 v = *(const LAS u32x4*)(T + n * 72 + kc);
            *(u32x4*)(Wt + (size_t)(n0 + n) * ldk + k0 + kc) = v; }
        __syncthreads();
#pragma unroll
        for (int i = 0; i < 4; ++i) { cur[i] = nxt[i]; gs[i] = gsn[i]; }
    }
}

__device__ void phase0(const Params& p, LAS unsigned char* lds) {
    const int tid = otid(), lane = tid & 63, wid = tid >> 6;
    const int gw = blockIdx.x * 8 + wid, nw = gridDim.x * 8;
    float* rs = (float*)(p.ws + WS_RS);
    { float* psv = (float*)(p.ws + WS_PSV); for (int i = blockIdx.x * 512 + tid; i < MP * 4; i += gridDim.x * 512) psv[(size_t)(i >> 2) * 16 + 12 + (i & 3)] = 0.f; }
    {
        bf16_t* XB = (bf16_t*)(p.ws + WS_XB);
        for (int row = gw; row < MV; row += nw) {
            const float* src = row < TPR ? p.in[0] + (size_t)row * 2048 : p.in[1] + (size_t)(row - TPR) * 2048;
            float ss = 0.f; f32x4 xv8[8];
#pragma unroll
            for (int i = 0; i < 8; ++i) xv8[i] = *(const f32x4*)(src + (i * 64 + lane) * 4);
#pragma unroll
            for (int i = 0; i < 8; ++i) { const int c = (i * 64 + lane) * 4; const f32x4 v = xv8[i];
                ss += v[0] * v[0] + v[1] * v[1] + v[2] * v[2] + v[3] * v[3];
                *(u32x2*)(XB + (size_t)row * 2048 + c) = pack4(v); }
#pragma unroll
            for (int o = 32; o > 0; o >>= 1) ss += __shfl_xor(ss, o);
            if (lane < 32) rs[(size_t)row * 32 + lane] = lane == 0 ? ss : 0.f;
        }
    }
    {
        bf16_t* MN = (bf16_t*)(p.ws + WS_MEMN);
        for (int row = gw; row < 1024; row += nw) {
            const float* src = p.in[7] + (size_t)row * 2048; f32x4 v[8]; float ss = 0.f;
#pragma unroll
            for (int i = 0; i < 8; ++i) { v[i] = *(const f32x4*)(src + (i * 64 + lane) * 4); ss += v[i][0] * v[i][0] + v[i][1] * v[i][1] + v[i][2] * v[i][2] + v[i][3] * v[i][3]; }
#pragma unroll
            for (int o = 32; o > 0; o >>= 1) ss += __shfl_xor(ss, o);
            const float r = rsqrtf(ss * (1.0f / 2048.0f) + EPSF);
#pragma unroll
            for (int l = 0; l < 2; ++l)
#pragma unroll
                for (int i = 0; i < 8; ++i) { const int c = (i * 64 + lane) * 4; const f32x4 g = *(const f32x4*)(p.in[14] + l * 2048 + c);
                    *(u32x2*)(MN + ((size_t)l * 1024 + row) * 2048 + c) = pack4(v[i] * g * r); }
        }
    }
    for (int i = blockIdx.x * 512 + tid; i < 2 * 128 * (DFF2 / 4); i += gridDim.x * 512) {
        const int ls = i / (DFF2 / 4), c = (i - ls * (DFF2 / 4)) * 4;
        *(f32x4*)(p.out + O_CS + ((size_t)ls * 2 + 0) * DFF2 + c) = *(const f32x4*)(p.in[6] + ((size_t)ls * 2 + 1) * DFF2 + c);
    }
    for (int i = blockIdx.x * 512 + tid; i < 2 * 2048 * 32; i += gridDim.x * 512) {
        const int l = i >> 16, r = (i >> 5) & 2047, c = (i & 31) * 8;
        *(u32x4*)((bf16_t*)(p.ws + WS_W) + (size_t)l * LW + oWBM + (size_t)r * 768 + 512 + c) = (u32x4){0u, 0u, 0u, 0u};
    }
    convert_tiles(p, lds, (int)blockIdx.x, 3648, (int)gridDim.x);
}

template <int HD, bool SWA>
__device__ __forceinline__ void attn_block16(const LAS bf16_t* Kl, const LAS bf16_t* VT, const bf16_t* qrow  ,
                                             bf16_t* orow0  , int ldo, int i0, bool first_blk, float slope, float sink) {
    constexpr int KS = HD + 8, VS = 264, NKS = HD / 32, NDB = HD / 16;
    const int lane = otid() & 63, r = lane & 15, quad = lane >> 4;
    bf16x8 qf[NKS];
#pragma unroll
    for (int ks = 0; ks < NKS; ++ks) qf[ks] = *(const bf16x8*)(qrow + ks * 32 + quad * 8);
    f32x4 st[16];
#pragma unroll
    for (int kb = 0; kb < 16; ++kb) { f32x4 a = {0.f, 0.f, 0.f, 0.f};
#pragma unroll
        for (int ks = 0; ks < NKS; ++ks) { const bf16x8 kf = *(const LAS bf16x8*)(Kl + (kb * 16 + r) * KS + ks * 32 + quad * 8);
            a = __builtin_amdgcn_mfma_f32_16x16x32_bf16(kf, qf[ks], a, 0, 0, 0); }
        st[kb] = a; __builtin_amdgcn_sched_barrier(0); }
    float mx = SWA ? sink : -INFINITY;
#pragma unroll
    for (int kb = 0; kb < 16; ++kb)
#pragma unroll
        for (int j = 0; j < 4; ++j) {
            if (SWA) { const int s = kb * 16 + quad * 4 + j, dist = i0 + r + 128 - s; const bool valid = dist >= 0 && dist <= 128 && (!first_blk || s >= 128);
                st[kb][j] = valid ? st[kb][j] - slope * (float)dist : -INFINITY; }
            mx = fmaxf(mx, st[kb][j]); }
    mx = fmaxf(mx, __shfl_xor(mx, 16)); mx = fmaxf(mx, __shfl_xor(mx, 32));
    float sum = 0.f;
#pragma unroll
    for (int kb = 0; kb < 16; ++kb)
#pragma unroll
        for (int j = 0; j < 4; ++j) { const float e = __expf(st[kb][j] - mx); st[kb][j] = e; sum += e; }
    sum += __shfl_xor(sum, 16); sum += __shfl_xor(sum, 32);
    if (SWA) sum += __expf(sink - mx);
    const float inv = __builtin_amdgcn_rcpf(sum);
    f32x4 o[NDB];
#pragma unroll
    for (int db = 0; db < NDB; ++db) o[db] = (f32x4){0.f, 0.f, 0.f, 0.f};
#pragma unroll
    for (int i = 0; i < 8; ++i) {
        union { bf16x8 v; unsigned u[4]; } pa;
        pa.u[0] = cvt_pk_bf16(st[2 * i][0] * inv, st[2 * i][1] * inv); pa.u[1] = cvt_pk_bf16(st[2 * i][2] * inv, st[2 * i][3] * inv);
        pa.u[2] = cvt_pk_bf16(st[2 * i + 1][0] * inv, st[2 * i + 1][1] * inv); pa.u[3] = cvt_pk_bf16(st[2 * i + 1][2] * inv, st[2 * i + 1][3] * inv);
#pragma unroll
        for (int db = 0; db < NDB; ++db) {
            union { bf16x8 v; u32x2 h[2]; } vb;
            vb.h[0] = *(const LAS u32x2*)(VT + (db * 16 + r) * VS + 32 * i + quad * 4);
            vb.h[1] = *(const LAS u32x2*)(VT + (db * 16 + r) * VS + 32 * i + 16 + quad * 4);
            o[db] = __builtin_amdgcn_mfma_f32_16x16x32_bf16(pa.v, vb.v, o[db], 0, 0, 0); }
        __builtin_amdgcn_sched_barrier(0); }
#pragma unroll
    for (int db = 0; db < NDB; ++db)
#pragma unroll
        for (int j = 0; j < 4; j += 2) { const unsigned pk = cvt_pk_bf16(o[db][j], o[db][j + 1]);
            orow0[(size_t)(quad * 4 + j) * ldo + db * 16 + r] = (bf16_t)(pk & 0xffff); orow0[(size_t)(quad * 4 + j + 1) * ldo + db * 16 + r] = (bf16_t)(pk >> 16); }
}

__device__ void mixer_phase(const Params& p, int l, LAS unsigned char* lds) {
    unsigned char* R1 = p.ws + WS_R1;
    const bf16_t* U = (const bf16_t*)(R1 + R_U); const float* GV = (const float*)(R1 + R_GV); const bf16_t* Q = (const bf16_t*)(R1 + R_Q);
    const bf16_t* KB = (const bf16_t*)(R1 + R_KB); const bf16_t* VB = (const bf16_t*)(R1 + R_VB); const bf16_t* MQ = (const bf16_t*)(R1 + R_MQ);
    bf16_t* OG = (bf16_t*)(R1 + R_OG); bf16_t* OA = (bf16_t*)(R1 + R_OA); bf16_t* OM = (bf16_t*)(R1 + R_OM);
    const bf16_t* MKV = (const bf16_t*)(p.ws + WS_MKV);
    const float* rsv = (const float*)(p.ws + WS_PSV);
    const float* sinks = p.in[13] + l * 12;
    float* out = p.out;
#ifndef MX
#define MX 0xff
#endif
    {
        if (MX & 1) for (int u = blockIdx.x; u < 256; u += gridDim.x) {
            const int tid = otid(), lane = tid & 63, wid = tid >> 6; (void)lane; (void)wid;
            const int b = u >> 6, nb = (u >> 2) & 15, kv = u & 3;
            LAS bf16_t* Kl = (LAS bf16_t*)lds; LAS bf16_t* VT = (LAS bf16_t*)(lds + 256 * 72 * 2);
#pragma unroll
            for (int i = 0; i < 4; ++i) { const int idx = tid + i * 512, s = idx >> 3, c8 = (idx & 7) * 8;
                const bool valid = nb > 0 || s >= 128; const size_t tok = (size_t)b * 2048 + nb * 128 - 128 + s;
                u32x4 kvv = {0u, 0u, 0u, 0u}, vv = {0u, 0u, 0u, 0u};
                if (valid) { kvv = *(const u32x4*)(KB + tok * 256 + kv * 64 + c8); vv = *(const u32x4*)(VB + tok * 256 + kv * 64 + c8); }
                *(LAS u32x4*)(Kl + s * 72 + c8) = kvv;
#pragma unroll
                for (int e = 0; e < 4; ++e) { VT[(c8 + 2 * e) * 264 + s] = (bf16_t)(vv[e] & 0xffff); VT[(c8 + 2 * e + 1) * 264 + s] = (bf16_t)(vv[e] >> 16); } }
            __syncthreads();
            const size_t tok0 = (size_t)b * 2048 + nb * 128 + wid * 16;
#pragma nounroll
            for (int g = 0; g < 3; ++g) { const int h = kv * 3 + g;
                attn_block16<64, true>(Kl, VT, Q + (tok0 + (lane & 15)) * 768 + h * 64, OA + tok0 * 768 + h * 64, 768, wid * 16, nb == 0, slope_of(h), sinks[h]); }
            __syncthreads();
        }
        if (MX & 2) for (int u = 256 + blockIdx.x; u < 512; u += gridDim.x) {
            const int tid = otid(), lane = tid & 63, wid = tid >> 6; (void)lane; (void)wid;
            const int v = u - 256, b = v >> 6, h = (v >> 4) & 3, qt = v & 15;
            LAS bf16_t* Kl = (LAS bf16_t*)lds; LAS bf16_t* VT = (LAS bf16_t*)(lds + 256 * 136 * 2);
#pragma unroll
            for (int i = 0; i < 8; ++i) { const int idx = tid + i * 512, s = idx >> 4, c8 = (idx & 15) * 8;
                const bf16_t* src = MKV + (size_t)(b * 256 + s) * 1024 + h * 128 + c8;
                const u32x4 kvv = *(const u32x4*)src, vv = *(const u32x4*)(src + 512);
                *(LAS u32x4*)(Kl + s * 136 + c8) = kvv;
#pragma unroll
                for (int e = 0; e < 4; ++e) { VT[(c8 + 2 * e) * 264 + s] = (bf16_t)(vv[e] & 0xffff); VT[(c8 + 2 * e + 1) * 264 + s] = (bf16_t)(vv[e] >> 16); } }
            __syncthreads();
            const size_t tok0 = (size_t)b * 2048 + qt * 128 + wid * 16;
            attn_block16<128, false>(Kl, VT, MQ + (tok0 + (lane & 15)) * 512 + h * 128, OM + tok0 * 768 + h * 128, 768, 0, false, 0.f, 0.f);
            __syncthreads();
        }
        if (MX & 4) for (int u = 512 + blockIdx.x; u < 1024; u += gridDim.x) {
            const int tid = otid(), lane = tid & 63, wid = tid >> 6; (void)lane; (void)wid;
            const int v = u - 512, b = v >> 7, ch = (v >> 3) & 15, g = v & 7;
            const size_t tok0 = (size_t)b * 2048 + ch * 128;
            LAS bf16_t* Wl = (LAS bf16_t*)lds; LAS bf16_t* VT = (LAS bf16_t*)(lds + 128 * 136 * 2);
            const float* wsrc = p.in[11] + ((size_t)l * 8 + g) * 128 * 128;
#pragma unroll
            for (int i = 0; i < 8; ++i) { const int idx = tid + i * 512, t = idx >> 5, s4 = (idx & 31) * 4;
                f32x4 w = *(const f32x4*)(wsrc + t * 128 + s4);
                w[0] = (s4 + 0 <= t) ? w[0] : 0.f; w[1] = (s4 + 1 <= t) ? w[1] : 0.f; w[2] = (s4 + 2 <= t) ? w[2] : 0.f; w[3] = (s4 + 3 <= t) ? w[3] : 0.f;
                *(LAS u32x2*)(Wl + t * 136 + s4) = pack4(w); }
#pragma unroll
            for (int i = 0; i < 6; ++i) { const int idx = tid + i * 512, s = idx / 24, c4 = (idx - s * 24) * 4;
                const float r = rsqrtf(rowsum16(rsv, (int)tok0 + s) * (1.0f / 768.0f) + EPSF);
                f32x4 vv = *(const f32x4*)(GV + (tok0 + s) * 768 + g * 96 + c4); const f32x4 gn = *(const f32x4*)(p.in[10] + l * 768 + g * 96 + c4);
                vv = vv * gn * r;
                if (ch == 15) *(f32x4*)(out + O_GVP + ((size_t)(l * 4 + b) * 128 + s) * 768 + g * 96 + c4) = vv;
                const u32x2 pk = pack4(vv);
                VT[(c4 + 0) * 136 + s] = (bf16_t)(pk.x & 0xffff); VT[(c4 + 1) * 136 + s] = (bf16_t)(pk.x >> 16);
                VT[(c4 + 2) * 136 + s] = (bf16_t)(pk.y & 0xffff); VT[(c4 + 3) * 136 + s] = (bf16_t)(pk.y >> 16); }
            __syncthreads();
            {
                const int r = lane & 15, quad = lane >> 4, t0 = wid * 16;
                f32x4 acc[6];
#pragma unroll
                for (int cbk = 0; cbk < 6; ++cbk) acc[cbk] = (f32x4){0.f, 0.f, 0.f, 0.f};
#pragma unroll
                for (int ks = 0; ks < 4; ++ks) { const bf16x8 a = *(const LAS bf16x8*)(Wl + (t0 + r) * 136 + ks * 32 + quad * 8);
#pragma unroll
                    for (int cbk = 0; cbk < 6; ++cbk) { const bf16x8 bb = *(const LAS bf16x8*)(VT + (cbk * 16 + r) * 136 + ks * 32 + quad * 8);
                        acc[cbk] = __builtin_amdgcn_mfma_f32_16x16x32_bf16(a, bb, acc[cbk], 0, 0, 0); } }
#pragma unroll
                for (int j = 0; j < 4; ++j) { const int t = t0 + quad * 4 + j; const float bs = p.in[12][((size_t)l * 8 + g) * 128 + t];
#pragma unroll
                    for (int cbk = 0; cbk < 6; ++cbk) { const size_t o = (tok0 + t) * 768 + g * 96 + cbk * 16 + r;
                        const float uu = bf2f(U[o]); OG[o] = (bf16_t)(cvt_pk_bf16(uu * (acc[cbk][j] + bs), 0.f) & 0xffff); } }
            }
            __syncthreads();
        }
        if (MX & 8) for (int u = 1024 + blockIdx.x; u < 1032; u += gridDim.x) {
            const int tid = otid(), lane = tid & 63, wid = tid >> 6; (void)lane; (void)wid;
            const int s0 = (u - 1024) * 16;
            for (int idx = tid; idx < 16 * 192; idx += 512) { const int s = s0 + idx / 192, c4 = (idx % 192) * 4, g = c4 / 96; const size_t row = TPR + s;
                const float r = rsqrtf(rowsum16(rsv, (int)row) * (1.0f / 768.0f) + EPSF);
                f32x4 vv = *(const f32x4*)(GV + row * 768 + c4); const f32x4 gn = *(const f32x4*)(p.in[10] + l * 768 + c4);
                vv = vv * gn * r;
                *(f32x4*)(out + O_GVS + ((size_t)l * 128 + s) * 768 + c4) = vv;
                const float w00 = p.in[11][((size_t)l * 8 + g) * 128 * 128], bs = p.in[12][((size_t)l * 8 + g) * 128];
                const u32x2 uu = *(const u32x2*)(U + row * 768 + c4);
                f32x4 o = {bflo(uu.x) * (w00 * vv[0] + bs), bfhi(uu.x) * (w00 * vv[1] + bs), bflo(uu.y) * (w00 * vv[2] + bs), bfhi(uu.y) * (w00 * vv[3] + bs)};
                *(u32x2*)(OG + row * 768 + c4) = pack4(o); }
        }
        if (MX & 16) for (int u = 1032 + blockIdx.x; u < 1544; u += gridDim.x) {
            const int tid = otid(), lane = tid & 63, wid = tid >> 6; (void)lane; (void)wid;
            const int v = u - 1032, s = v >> 2, kv = v & 3; const size_t row = TPR + s;
            LAS float* sc = (LAS float*)lds; LAS float* red = (LAS float*)(lds + 3 * 132 * 4);
            const float* ck = p.in[2] + (size_t)(l * 128 + s) * 128 * 256 + kv * 64; const float* cv = p.in[3] + (size_t)(l * 128 + s) * 128 * 256 + kv * 64;
            float* ok = out + O_KS + (size_t)(l * 128 + s) * 128 * 256 + kv * 64; float* ov = out + O_VS + (size_t)(l * 128 + s) * 128 * 256 + kv * 64;
            {
                const int c = lane & 15, q4 = lane >> 4; float qv[3][4];
#pragma unroll
                for (int g = 0; g < 3; ++g) { const u32x2 qq = *(const u32x2*)(Q + row * 768 + (kv * 3 + g) * 64 + c * 4); qv[g][0] = bflo(qq.x); qv[g][1] = bfhi(qq.x); qv[g][2] = bflo(qq.y); qv[g][3] = bfhi(qq.y); }
                f32x4 kk5[5];
#pragma unroll
                for (int ps = 0; ps < 5; ++ps) { const int j = ps * 32 + wid * 4 + q4; kk5[ps] = (f32x4){0.f, 0.f, 0.f, 0.f};
                    if (j <= 128) kk5[ps] = (j < 128) ? *(const f32x4*)(ck + (size_t)j * 256 + c * 4) : *(const f32x4*)(ok + (size_t)127 * 256 + c * 4); }
#pragma unroll
                for (int ps = 0; ps < 5; ++ps) { const int j = ps * 32 + wid * 4 + q4;
                    if (j <= 128) {
                        const f32x4 kk = kk5[ps];
                        if (j >= 1 && j < 128) *(f32x4*)(ok + (size_t)(j - 1) * 256 + c * 4) = kk;
                        float d0 = kk[0] * qv[0][0] + kk[1] * qv[0][1] + kk[2] * qv[0][2] + kk[3] * qv[0][3];
                        float d1 = kk[0] * qv[1][0] + kk[1] * qv[1][1] + kk[2] * qv[1][2] + kk[3] * qv[1][3];
                        float d2 = kk[0] * qv[2][0] + kk[1] * qv[2][1] + kk[2] * qv[2][2] + kk[3] * qv[2][3];
#pragma unroll
                        for (int o = 8; o > 0; o >>= 1) { d0 += __shfl_xor(d0, o); d1 += __shfl_xor(d1, o); d2 += __shfl_xor(d2, o); }
                        if (c == 0) { const float dist = (float)(128 - j);
                            sc[0 * 132 + j] = d0 - slope_of(kv * 3 + 0) * dist; sc[1 * 132 + j] = d1 - slope_of(kv * 3 + 1) * dist; sc[2 * 132 + j] = d2 - slope_of(kv * 3 + 2) * dist; } } }
            }
            __syncthreads();
            if (wid < 3) { const float sink = sinks[kv * 3 + wid]; LAS float* sr = sc + wid * 132;
                const float v0 = sr[lane], v1 = sr[lane + 64], v2 = lane == 0 ? sr[128] : -INFINITY;
                float mx = fmaxf(fmaxf(v0, v1), fmaxf(v2, sink));
#pragma unroll
                for (int o = 32; o > 0; o >>= 1) mx = fmaxf(mx, __shfl_xor(mx, o));
                const float e0 = __expf(v0 - mx), e1 = __expf(v1 - mx), e2 = lane == 0 ? __expf(v2 - mx) : 0.f;
                float sum = e0 + e1 + e2;
#pragma unroll
                for (int o = 32; o > 0; o >>= 1) sum += __shfl_xor(sum, o);
                sum += __expf(sink - mx); const float inv = 1.0f / sum;
                sr[lane] = e0 * inv; sr[lane + 64] = e1 * inv; if (lane == 0) sr[128] = e2 * inv; }
            __syncthreads();
            { const int jg = wid, d = lane; float a0 = 0.f, a1 = 0.f, a2 = 0.f;
                float vv17[17];
#pragma unroll
                for (int it = 0; it < 17; ++it) { const int j = jg + it * 8; vv17[it] = 0.f;
                    if (j <= 128) vv17[it] = (j < 128) ? cv[(size_t)j * 256 + d] : ov[(size_t)127 * 256 + d]; }
#pragma unroll
                for (int it = 0; it < 17; ++it) { const int j = jg + it * 8;
                    if (j <= 128) { const float vv = vv17[it];
                        if (j >= 1 && j < 128) ov[(size_t)(j - 1) * 256 + d] = vv;
                        a0 += sc[j] * vv; a1 += sc[132 + j] * vv; a2 += sc[264 + j] * vv; } }
                red[(jg * 3 + 0) * 64 + d] = a0; red[(jg * 3 + 1) * 64 + d] = a1; red[(jg * 3 + 2) * 64 + d] = a2; }
            __syncthreads();
            if (tid < 192) { const int g = tid >> 6, d = tid & 63; float a = 0.f;
#pragma unroll
                for (int jg = 0; jg < 8; ++jg) a += red[(jg * 3 + g) * 64 + d];
                OA[row * 768 + (kv * 3 + g) * 64 + d] = (bf16_t)(cvt_pk_bf16(a, 0.f) & 0xffff); }
            __syncthreads();
        }
        if (MX & 32) for (int u = 1544 + blockIdx.x; u < 2056; u += gridDim.x) {
            const int tid = otid(), lane = tid & 63, wid = tid >> 6; (void)lane; (void)wid;
            const int v = u - 1544, s = v >> 2, h = v & 3; const size_t row = TPR + s;
            LAS float* sc = (LAS float*)lds; LAS float* red = (LAS float*)(lds + 256 * 4);
            const float* ck = p.in[4] + (size_t)(l * 128 + s) * 256 * 512 + h * 128; const float* cv = p.in[5] + (size_t)(l * 128 + s) * 256 * 512 + h * 128;
            {
                const int c = lane & 31, q2 = lane >> 5; const u32x2 qq = *(const u32x2*)(MQ + row * 512 + h * 128 + c * 4);
                const float q0 = bflo(qq.x), q1 = bfhi(qq.x), q2f = bflo(qq.y), q3 = bfhi(qq.y);
#pragma unroll
                for (int ps = 0; ps < 16; ++ps) { const int m = ps * 16 + wid * 2 + q2; const f32x4 kk = *(const f32x4*)(ck + (size_t)m * 512 + c * 4);
                    float d = kk[0] * q0 + kk[1] * q1 + kk[2] * q2f + kk[3] * q3;
#pragma unroll
                    for (int o = 16; o > 0; o >>= 1) d += __shfl_xor(d, o);
                    if (c == 0) sc[m] = d; }
            }
            __syncthreads();
            if (wid == 0) { const float v0 = sc[lane], v1 = sc[lane + 64], v2 = sc[lane + 128], v3 = sc[lane + 192];
                float mx = fmaxf(fmaxf(v0, v1), fmaxf(v2, v3));
#pragma unroll
                for (int o = 32; o > 0; o >>= 1) mx = fmaxf(mx, __shfl_xor(mx, o));
                const float e0 = __expf(v0 - mx), e1 = __expf(v1 - mx), e2 = __expf(v2 - mx), e3 = __expf(v3 - mx);
                float sum = e0 + e1 + e2 + e3;
#pragma unroll
                for (int o = 32; o > 0; o >>= 1) sum += __shfl_xor(sum, o);
                const float inv = 1.0f / sum;
                sc[lane] = e0 * inv; sc[lane + 64] = e1 * inv; sc[lane + 128] = e2 * inv; sc[lane + 192] = e3 * inv; }
            __syncthreads();
            { const int mg = tid >> 5, c = tid & 31; f32x4 a = {0.f, 0.f, 0.f, 0.f};
#pragma unroll
                for (int it = 0; it < 16; ++it) { const int m = mg + it * 16; const f32x4 vv = *(const f32x4*)(cv + (size_t)m * 512 + c * 4); a += vv * sc[m]; }
                *(LAS f32x4*)(red + mg * 128 + c * 4) = a; }
            __syncthreads();
            if (tid < 128) { float a = 0.f;
#pragma unroll
                for (int mg = 0; mg < 16; ++mg) a += red[mg * 128 + tid];
                OM[row * 768 + h * 128 + tid] = (bf16_t)(cvt_pk_bf16(a, 0.f) & 0xffff); }
            __syncthreads();
        }
    }
}

__device__ void conv_phase(const Params& p, int l) {
    const bf16_t* H = (const bf16_t*)(p.ws + WS_R1 + R_H); bf16_t* ACT = (bf16_t*)(p.ws + WS_ACT);
    const float* cw = p.in[22] + (size_t)l * 3 * DFF2; const float* cb = p.in[23] + (size_t)l * DFF2;
    constexpr int NJ = DFF / 8;
    const int nitems = 256 * NJ + 128 * NJ;
    for (int it = blockIdx.x * 512 + otid(); it < nitems; it += gridDim.x * 512) {
        const bool samp = it >= 256 * NJ; const int it2 = samp ? it - 256 * NJ : it; const int rb = it2 / NJ, j = (it2 - rb * NJ) * 8;
        float w[2][3][8], bias[2][8], h1[2][8], h2[2][8];
#pragma unroll
        for (int ab = 0; ab < 2; ++ab) {
#pragma unroll
            for (int k = 0; k < 3; ++k) { const f32x4 x0 = *(const f32x4*)(cw + (size_t)k * DFF2 + ab * DFF + j), x1 = *(const f32x4*)(cw + (size_t)k * DFF2 + ab * DFF + j + 4);
#pragma unroll
                for (int e = 0; e < 4; ++e) { w[ab][k][e] = x0[e]; w[ab][k][4 + e] = x1[e]; } }
            const f32x4 b0 = *(const f32x4*)(cb + ab * DFF + j), b1 = *(const f32x4*)(cb + ab * DFF + j + 4);
#pragma unroll
            for (int e = 0; e < 4; ++e) { bias[ab][e] = b0[e]; bias[ab][4 + e] = b1[e]; } }
        int row0, nrows;
        if (samp) { row0 = TPR + rb; nrows = 1;
#pragma unroll
            for (int ab = 0; ab < 2; ++ab) { const float* st = p.in[6] + ((size_t)(l * 128 + rb) * 2) * DFF2 + ab * DFF + j;
                const f32x4 a0 = *(const f32x4*)(st), a1 = *(const f32x4*)(st + 4), c0 = *(const f32x4*)(st + DFF2), c1 = *(const f32x4*)(st + DFF2 + 4);
#pragma unroll
                for (int e = 0; e < 4; ++e) { h2[ab][e] = a0[e]; h2[ab][4 + e] = a1[e]; h1[ab][e] = c0[e]; h1[ab][4 + e] = c1[e]; } }
        } else { row0 = rb * 32; nrows = 32; const bool first = (row0 & 2047) == 0;
#pragma unroll
            for (int ab = 0; ab < 2; ++ab) {
                u32x4 a = {0u, 0u, 0u, 0u}, c = {0u, 0u, 0u, 0u};
                if (!first) { a = *(const u32x4*)(H + (size_t)(row0 - 2) * DFF2 + ab * DFF + j); c = *(const u32x4*)(H + (size_t)(row0 - 1) * DFF2 + ab * DFF + j); }
#pragma unroll
                for (int e = 0; e < 4; ++e) { h2[ab][2 * e] = bflo(a[e]); h2[ab][2 * e + 1] = bfhi(a[e]); h1[ab][2 * e] = bflo(c[e]); h1[ab][2 * e + 1] = bfhi(c[e]); } }
        }
        for (int r0 = 0; r0 < nrows; r0 += 8) {
            u32x4 hav[8], hbv[8];
#pragma unroll
            for (int i = 0; i < 8; ++i) { hav[i] = (u32x4){0u, 0u, 0u, 0u}; hbv[i] = hav[i];
                if (r0 + i < nrows) { const size_t row = (size_t)row0 + r0 + i; hav[i] = *(const u32x4*)(H + row * DFF2 + j); hbv[i] = *(const u32x4*)(H + row * DFF2 + DFF + j); } }
#pragma unroll
            for (int i = 0; i < 8; ++i) if (r0 + i < nrows) { const size_t row = (size_t)row0 + r0 + i; const u32x4 ha = hav[i], hb = hbv[i];
                float h0[2][8];
#pragma unroll
                for (int e = 0; e < 4; ++e) { h0[0][2 * e] = bflo(ha[e]); h0[0][2 * e + 1] = bfhi(ha[e]); h0[1][2 * e] = bflo(hb[e]); h0[1][2 * e + 1] = bfhi(hb[e]); }
                float o[8];
#pragma unroll
                for (int e = 0; e < 8; ++e) {
                    const float a = bias[0][e] + h2[0][e] * w[0][0][e] + h1[0][e] * w[0][1][e] + h0[0][e] * w[0][2][e];
                    const float b = bias[1][e] + h2[1][e] * w[1][0][e] + h1[1][e] * w[1][1][e] + h0[1][e] * w[1][2][e];
                    o[e] = gelu_t(a) * b; h2[0][e] = h1[0][e]; h1[0][e] = h0[0][e]; h2[1][e] = h1[1][e]; h1[1][e] = h0[1][e]; }
                u32x4 pk = {cvt_pk_bf16(o[0], o[1]), cvt_pk_bf16(o[2], o[3]), cvt_pk_bf16(o[4], o[5]), cvt_pk_bf16(o[6], o[7])};
                *(u32x4*)(ACT + row * DFF + j) = pk; }
        }
    }
}

__device__ void final_phase(const Params& p, const float* rs) {
    const int tidf = otid(), lane = tidf & 63, gw = blockIdx.x * 8 + (tidf >> 6), nw = gridDim.x * 8;
    const bf16_t* XBf = (const bf16_t*)(p.ws + WS_XB); const float* g = p.in[25];
    for (int row = gw; row < MV; row += nw) { const float r = rsqrtf(rowsum32(rs, row) * (1.0f / 2048.0f) + EPSF);
        u32x2 t8[8];
#pragma unroll
        for (int i = 0; i < 8; ++i) t8[i] = *(const u32x2*)(XBf + (size_t)row * 2048 + (i * 64 + lane) * 4);
#pragma unroll
        for (int i = 0; i < 8; ++i) { const int c = (i * 64 + lane) * 4; const u32x2 t = t8[i]; const f32x4 v = {bflo(t.x), bfhi(t.x), bflo(t.y), bfhi(t.y)}, gg = *(const f32x4*)(g + c);
            *(f32x4*)(p.out + O_Y + (size_t)row * 2048 + c) = v * gg * r; } }
}

__device__ __forceinline__ void fill_row_scales(const pg8::Sched& S, const float* ps, LAS float* rsl) {
    const int t = otid(), half = t >> 8, tr = t & 255;
#pragma unroll 1
    for (int i = half; i < 6; i += 2) { Unit u; const bool ok = S.next(i, u);
        if (ok) { int row = u.pm * 256 + tr; row = row < MV ? row : MV - 1; const f32x4* q = (const f32x4*)(ps + (size_t)row * 32);
            f32x4 a = q[0];
#pragma unroll
            for (int k = 1; k < 8; ++k) a += q[k];
            rsl[i * 256 + tr] = rsqrtf(((a[0] + a[1]) + (a[2] + a[3])) * (1.0f / 2048.0f) + EPSF); } }
    __syncthreads();
}

__device__ __forceinline__ void branch_rows_skinny(const bf16_t* OG, const bf16_t* OA, const bf16_t* OM, const bf16_t* WG, const bf16_t* WA, const bf16_t* WM,
                                                   const bf16_t* GT, bf16_t* MG, int c) {
    const int t = otid(), lane = t & 63, w = t >> 6, r = lane & 15, quad = lane >> 4;
    const int col0 = c * 16;
    f32x4 m = {0.f, 0.f, 0.f, 0.f};
#pragma unroll 1
    for (int s = 0; s < 3; ++s) {
        const bf16_t* A = (s == 0 ? OG : (s == 1 ? OA : OM)) + (size_t)(TPR + w * 16 + r) * 768 + quad * 8;
        const bf16_t* B = (s == 0 ? WG : (s == 1 ? WA : WM)) + (size_t)(col0 + r) * 768 + quad * 8;
        const int kend = s == 2 ? 512 : 768;
        f32x4 acc = {0.f, 0.f, 0.f, 0.f};
#pragma unroll 8
        for (int k0 = 0; k0 < kend; k0 += 32) { const bf16x8 a = *(const bf16x8*)(A + k0), b = *(const bf16x8*)(B + k0); acc = __builtin_amdgcn_mfma_f32_16x16x32_bf16(a, b, acc, 0, 0, 0); }
#pragma unroll
        for (int j = 0; j < 4; ++j) { const size_t row = (size_t)(TPR + w * 16 + quad * 4 + j); m[j] += bf2f(GT[row * 6144 + s * 2048 + col0 + r]) * acc[j]; }
    }
#pragma unroll
    for (int j = 0; j < 4; ++j) { const size_t row = (size_t)(TPR + w * 16 + quad * 4 + j); MG[row * 2048 + col0 + r] = (bf16_t)(cvt_pk_bf16(m[j], 0.f) & 0xffff); }
}

#ifdef SIMPLE_GEMM
#define GEMM_CALL(lds, g, S, E) pg8::gemm_simple(g, S, E)
#else
#define GEMM_CALL(lds, g, S, E) pg8::gemm_phase(lds, g, S, E)
#endif
template <int SUB> __device__ __forceinline__ void run_sub(const Params& p, int l, LAS unsigned char* lds) {
    const int G = gridDim.x, c = blockIdx.x; (void)G; (void)c;
    unsigned char* ws = p.ws; unsigned char* R1 = ws + WS_R1; (void)R1;
    float* rs = (float*)(ws + WS_RS); (void)rs;
    constexpr int sub = SUB; constexpr int ph = SUB < 0 ? 0 : 1;
        const bf16_t* wb = (const bf16_t*)(ws + WS_W) + (size_t)l * LW;
        if constexpr (sub < 0) phase0(p, lds);
        else if constexpr (sub == 0) {
            pg8::Gemm g; g.A0 = (const bf16_t*)(ws + WS_XB); g.B0 = wb + oWIN; g.A1 = (const bf16_t*)(ws + WS_MEMN) + (size_t)l * 1024 * 2048; g.B1 = wb + oWMEM; g.A2 = g.A0; g.B2 = g.B0; g.K = 2048;
            pg8::Sched S; S.init(33, 37, G, c, 1, 16, 4);
            EpiB E; E.l = l; E.rsx = rs; E.rsv = (float*)(ws + WS_PSV); E.out = p.out;
            E.U = (bf16_t*)(R1 + R_U); E.Q = (bf16_t*)(R1 + R_Q); E.KB = (bf16_t*)(R1 + R_KB); E.VB = (bf16_t*)(R1 + R_VB); E.MQ = (bf16_t*)(R1 + R_MQ); E.GT = (bf16_t*)(R1 + R_GT);
            E.MKV = (bf16_t*)(ws + WS_MKV); E.GV = (float*)(R1 + R_GV);
            E.rsl = (const LAS float*)(lds + pg8::STAGE_BYTES); fill_row_scales(S, rs, (LAS float*)(lds + pg8::STAGE_BYTES));
            GEMM_CALL(lds, g, S, E);
        } else if constexpr (sub == 1) mixer_phase(p, l, lds);
        else if constexpr (sub == 2) {
            pg8::Gemm g; g.A0 = (const bf16_t*)(R1 + R_OG); g.A1 = (const bf16_t*)(R1 + R_OA); g.A2 = (const bf16_t*)(R1 + R_OM); g.B0 = wb + oWBG; g.B1 = wb + oWBA; g.B2 = wb + oWBM; g.K = 768;
            pg8::Sched S; S.init(32, 8, G, c, 3, 0, 1);
            EpiD E; E.GT = (const bf16_t*)(R1 + R_GT); E.MG = (bf16_t*)(ws + WS_MG);
            GEMM_CALL(lds, g, S, E);
            for (int cc = c; cc < 128; cc += G) branch_rows_skinny(g.A0, g.A1, g.A2, g.B0, g.B1, g.B2, E.GT, E.MG, cc);
            if (l == 0) { __syncthreads(); convert_tiles(p, lds, 3648 + c, 6464, G); convert_tiles(p, lds, 7872 + c, 11776, G); }
        } else if constexpr (sub == 3) {
            pg8::Gemm g; g.A0 = g.A1 = g.A2 = (const bf16_t*)(ws + WS_MG); g.B0 = g.B1 = g.B2 = wb + oWOUT; g.K = 2048;
            pg8::Sched S; S.init(32, 8, G, c, 1, 4 * 8, 8, 8);
            EpiR E; E.xs0 = l == 0 ? p.in[0] : nullptr; E.xs1 = l == 0 ? p.in[1] : nullptr;
            E.XB = (bf16_t*)(ws + WS_XB); E.rs = rs;
            E.part = (float*)(ws + WS_PART) + (size_t)(l * 2) * (22 * 8 * 128 * 256); E.ctr = (unsigned*)(ws + WS_BAR) + 768 + (l * 2) * 64; E.nc = 4;
            GEMM_CALL(lds, g, S, E);
            if (l == 0 && c >= 32) { __syncthreads(); convert_tiles(p, lds, 6464 + (c - 32), 7872, G - 32); }
        } else if constexpr (sub == 4) {
            pg8::Gemm g; g.A0 = g.A1 = g.A2 = (const bf16_t*)(ws + WS_XB); g.B0 = g.B1 = g.B2 = wb + oWUP; g.K = 2048;
            pg8::Sched S; S.init(33, 44, G, c, 1, 0, 1);
            EpiF E; E.l = l; E.rsf = rs; E.H = (bf16_t*)(R1 + R_H); E.out = p.out;
            E.rsl = (const LAS float*)(lds + pg8::STAGE_BYTES); fill_row_scales(S, rs, (LAS float*)(lds + pg8::STAGE_BYTES));
            GEMM_CALL(lds, g, S, E);
        } else if constexpr (sub == 5) conv_phase(p, l);
        else if constexpr (sub == 6) {
            pg8::Gemm g; g.A0 = g.A1 = g.A2 = (const bf16_t*)(ws + WS_ACT); g.B0 = g.B1 = g.B2 = wb + oWDN; g.K = DFF;
            pg8::Sched S; S.init(32, 8, G, c, 1, 4 * 8, 8, 22);
            EpiR E; E.xs0 = nullptr; E.xs1 = nullptr;
            E.XB = (bf16_t*)(ws + WS_XB); E.rs = rs;
            E.part = (float*)(ws + WS_PART) + (size_t)(l * 2 + 1) * (22 * 8 * 128 * 256); E.ctr = (unsigned*)(ws + WS_BAR) + 768 + (l * 2 + 1) * 64; E.nc = 4;
            GEMM_CALL(lds, g, S, E);
            if (l == 0 && c >= 32) { __syncthreads(); convert_tiles(p, lds, 11776 + (c - 32), 15744, G - 32); }
        } else final_phase(p, rs);
}
template <int SUB> __global__ void __launch_bounds__(512) k_sub(Params p) {
    extern __shared__ __attribute__((aligned(16))) unsigned char shm[];
    run_sub<SUB>(p, p.ph_lo, (LAS unsigned char*)shm);
}
#ifndef ONE_LAUNCH
#define ONE_LAUNCH 1
#endif
__global__ void __launch_bounds__(512) fwd_mk(Params p) {
    extern __shared__ __attribute__((aligned(16))) unsigned char shm[];
    LAS unsigned char* lds = (LAS unsigned char*)shm;
    cg::grid_group grid = cg::this_grid();
    unsigned* gb = (unsigned*)(p.ws + WS_BAR); unsigned gb_target = 0, gb_k = 0, gb_nx = 0;
    const unsigned gb_x = (unsigned)__builtin_amdgcn_s_getreg((3 << 11) | 20) & 0xFu;
    if (p.ws == nullptr) grid.sync();
#define GB_LD(pw) __hip_atomic_load((pw), __ATOMIC_RELAXED, __HIP_MEMORY_SCOPE_AGENT)
#define GB_ADD(pw, v) __hip_atomic_fetch_add((pw), (v), __ATOMIC_RELAXED, __HIP_MEMORY_SCOPE_AGENT)
#define GSYNC() do { gb_target += gridDim.x; ++gb_k; \
        asm volatile("s_waitcnt vmcnt(0)" ::: "memory"); __syncthreads(); \
        if (threadIdx.x < 64) { \
            if (gb_k == 1) { \
                __builtin_amdgcn_fence(__ATOMIC_RELEASE, "agent"); asm volatile("s_waitcnt vmcnt(0)" ::: "memory"); \
                if (threadIdx.x == 0) { GB_ADD(gb + 64 + 16 * gb_x, 1u); GB_ADD(gb, 1u); \
                    while (GB_LD(gb) < gb_target) __builtin_amdgcn_s_sleep(1); \
                    gb_nx = GB_LD(gb + 64 + 16 * gb_x); } \
            } else if (threadIdx.x == 0) { \
                const unsigned old = GB_ADD(gb + 384 + 16 * gb_x, 1u); \
                if (old + 1u == gb_nx * (gb_k - 1u)) { __builtin_amdgcn_fence(__ATOMIC_RELEASE, "agent"); asm volatile("s_waitcnt vmcnt(0)" ::: "memory"); GB_ADD(gb, gb_nx); } \
                while (GB_LD(gb) < gb_target) __builtin_amdgcn_s_sleep(1); \
            } \
            __builtin_amdgcn_fence(__ATOMIC_ACQUIRE, "agent"); asm volatile("s_waitcnt vmcnt(0)" ::: "memory"); } \
        __syncthreads(); } while (0)
    run_sub<-1>(p, 0, lds); GSYNC();
    for (int l = 0; l < 2; ++l) {
        run_sub<0>(p, l, lds); GSYNC();
        run_sub<1>(p, l, lds); GSYNC();
        run_sub<2>(p, l, lds); GSYNC();
        run_sub<3>(p, l, lds); GSYNC();
        run_sub<4>(p, l, lds); GSYNC();
        run_sub<5>(p, l, lds); GSYNC();
        run_sub<6>(p, l, lds); GSYNC();
    }
    run_sub<7>(p, 0, lds);
}
template <int SUB> static void launch_sub(const Params& p0, int l, int grid, hipStream_t stream) {
    static bool attr = false; if (!attr) { (void)hipFuncSetAttribute((const void*)k_sub<SUB>, hipFuncAttributeMaxDynamicSharedMemorySize, LDS_BYTES); attr = true; }
    Params p = p0; p.ph_lo = l; p.ph_hi = 0;
    hipLaunchKernelGGL(k_sub<SUB>, dim3(grid), dim3(512), LDS_BYTES, stream, p);
}

extern "C" void kernel_launch(void* const* d_in, const int* in_sizes, int n_in, void* d_out, int out_size, void* d_ws, size_t ws_size, hipStream_t stream) {
    static int grid_blocks = 0;
    if (!grid_blocks) {
        int dev = 0, cus = 0;
        (void)hipGetDevice(&dev);
        (void)hipDeviceGetAttribute(&cus, hipDeviceAttributeMultiprocessorCount, dev);
        grid_blocks = cus > 0 ? cus : 256;
    }
    if (ws_size < WS_END) return;
    Params p{};
    for (int i = 0; i < 26; ++i) p.in[i] = (const float*)d_in[i];
    p.out = (float*)d_out; p.ws = (unsigned char*)d_ws;
    if (ONE_LAUNCH) {
#ifdef REP_MASK
        p.ph_hi = REP_MASK;
#endif
        static bool attr = false; if (!attr) { (void)hipFuncSetAttribute((const void*)fwd_mk, hipFuncAttributeMaxDynamicSharedMemorySize, LDS_BYTES); attr = true; }
        (void)hipMemsetAsync((char*)d_ws + WS_BAR, 0, 4096, stream);
        void* args[] = {&p};
        hipError_t e = hipLaunchCooperativeKernel((void*)fwd_mk, dim3(grid_blocks), dim3(512), args, LDS_BYTES, stream);
        if (e != hipSuccess) fprintf(stderr, "cooperative launch failed: %s (grid %d)\n", hipGetErrorString(e), grid_blocks);
        return;
    }
    launch_sub<-1>(p, 0, grid_blocks, stream);
    for (int l = 0; l < 2; ++l) {
        launch_sub<0>(p, l, grid_blocks, stream); launch_sub<1>(p, l, grid_blocks, stream); launch_sub<2>(p, l, grid_blocks, stream); launch_sub<3>(p, l, grid_blocks, stream);
        launch_sub<4>(p, l, grid_blocks, stream); launch_sub<5>(p, l, grid_blocks, stream); launch_sub<6>(p, l, grid_blocks, stream);
    }
    launch_sub<7>(p, 0, grid_blocks, stream);
}
```

```cpp
#include <hip/hip_runtime.h>
#include <hip/hip_cooperative_groups.h>
#include <cstdio>
namespace cg = cooperative_groups;

#define LAS __attribute__((address_space(3)))
typedef unsigned short bf16_t;
typedef short bf16x8 __attribute__((ext_vector_type(8)));
typedef short bf16x4 __attribute__((ext_vector_type(4)));
typedef float f32x4 __attribute__((ext_vector_type(4)));
typedef unsigned u32x4 __attribute__((ext_vector_type(4)));
typedef unsigned u32x2 __attribute__((ext_vector_type(2)));

constexpr int DM = 2048, TPR = 8192, MV = 8320, MP = 8448, DFF = 5632, DFF2 = 11264;
constexpr float EPSF = 1e-6f;
constexpr size_t oWIN = 0, oWMEM = 19398656, oWBG = 21495808, oWBA = 23068672, oWBM = 24641536, oWOUT = 26214400, oWUP = 30408704, oWDN = 53477376, LW = 65011712;
constexpr size_t WS_W = 0;
constexpr size_t WS_X = WS_W + 2 * LW * 2;
constexpr size_t WS_XB = WS_X + (size_t)MP * DM * 4;
constexpr size_t WS_MG = WS_XB + (size_t)MP * DM * 2;
constexpr size_t WS_ACT = WS_MG + (size_t)MP * DM * 2;
constexpr size_t WS_MEMN = WS_ACT + (size_t)MP * DFF * 2;
constexpr size_t WS_MKV = WS_MEMN + (size_t)2 * 1024 * 2048 * 2;
constexpr size_t WS_RS = WS_MKV + (size_t)1024 * 1024 * 2;
constexpr size_t WS_PSV = WS_RS + (size_t)MP * 32 * 4;
constexpr size_t WS_R1 = WS_PSV + (size_t)MP * 16 * 4;
constexpr size_t R_GT = 0;
constexpr size_t R_U = R_GT + (size_t)MP * 6144 * 2;
constexpr size_t R_GV = R_U + (size_t)MP * 768 * 2;
constexpr size_t R_Q = R_GV + (size_t)MP * 768 * 4;
constexpr size_t R_KB = R_Q + (size_t)MP * 768 * 2;
constexpr size_t R_VB = R_KB + (size_t)MP * 256 * 2;
constexpr size_t R_MQ = R_VB + (size_t)MP * 256 * 2;
constexpr size_t R_OG = R_MQ + (size_t)MP * 512 * 2;
constexpr size_t R_OA = R_OG + (size_t)MP * 768 * 2;
constexpr size_t R_OM = R_OA + (size_t)MP * 768 * 2;
constexpr size_t R_END = R_OM + (size_t)MP * 768 * 2;
constexpr size_t R_H = 0;
constexpr size_t WS_BAR = WS_R1 + R_END;
constexpr size_t WS_PART = WS_BAR + 4096;
constexpr size_t WS_END = WS_PART + (size_t)4 * 22 * 8 * 128 * 256 * 4;
constexpr size_t O_Y = 0, O_KP = 17039360, O_VP = 17301504, O_KS = 17563648, O_VS = 25952256, O_MK = 34340864, O_MV = 35389440,
                 O_GVP = 36438016, O_GVS = 37224448, O_CP = 37421056, O_CS = 37601280;
constexpr int LDS_BYTES = 140 * 1024;

struct Params { const float* in[26]; float* out; unsigned char* ws; int ph_lo, ph_hi; };

typedef float f32x2_t __attribute__((ext_vector_type(2)));
typedef __bf16 bf16v2_t __attribute__((ext_vector_type(2)));
__device__ __forceinline__ unsigned cvt_pk_bf16(float lo, float hi) { const f32x2_t f = {lo, hi}; const bf16v2_t b = __builtin_convertvector(f, bf16v2_t); return __builtin_bit_cast(unsigned, b); }
__device__ __forceinline__ float bf2f(unsigned short b) { return __uint_as_float(((unsigned)b) << 16); }
__device__ __forceinline__ float bflo(unsigned u) { return __uint_as_float(u << 16); }
__device__ __forceinline__ float bfhi(unsigned u) { return __uint_as_float(u & 0xffff0000u); }
__device__ __forceinline__ float gelu_t(float x) { const float u = 1.5957691216f * (x + 0.044715f * x * x * x); return x * __builtin_amdgcn_rcpf(1.0f + __expf(-u)); }
__device__ __forceinline__ float sigmoid_f(float z) { return __builtin_amdgcn_rcpf(1.0f + __expf(-z)); }
__device__ __forceinline__ u32x2 pack4(f32x4 v) { u32x2 r; r.x = cvt_pk_bf16(v[0], v[1]); r.y = cvt_pk_bf16(v[2], v[3]); return r; }
__device__ __forceinline__ float slope_of(int h) { return h < 8 ? exp2f(-(float)(h + 1)) : exp2f(-((float)(h - 8) + 0.5f)); }

__device__ __forceinline__ int otid() { int t = threadIdx.x; asm volatile("" : "+v"(t)); return t; }

__device__ __forceinline__ u32x2 ld8c(const void* p) { const unsigned long long v = __hip_atomic_load((const unsigned long long*)p, __ATOMIC_RELAXED, __HIP_MEMORY_SCOPE_AGENT); u32x2 r; r.x = (unsigned)v; r.y = (unsigned)(v >> 32); return r; }
__device__ __forceinline__ u32x4 ld16_sc1(const void* p) { u32x4 v; asm volatile("global_load_dwordx4 %0, %1, off sc0 sc1\n\ts_waitcnt vmcnt(0)" : "=v"(v) : "v"(p) : "memory"); return v; }
__device__ __forceinline__ f32x4 ldf4_sc1(const void* p) { f32x4 v; asm volatile("global_load_dwordx4 %0, %1, off sc0 sc1\n\ts_waitcnt vmcnt(0)" : "=v"(v) : "v"(p) : "memory"); return v; }
__device__ __forceinline__ float rowsum32(const float* ps, int row) { const f32x4* q = (const f32x4*)(ps + (size_t)row * 32); f32x4 a = q[0];
#pragma unroll
    for (int i = 1; i < 8; ++i) a += q[i];
    return (a[0] + a[1]) + (a[2] + a[3]); }
__device__ __forceinline__ float rowsum16(const float* ps, int row) { const f32x4* q = (const f32x4*)(ps + (size_t)row * 16); f32x4 a = (q[0] + q[1]) + (q[2] + q[3]); return (a[0] + a[1]) + (a[2] + a[3]); }

namespace pg8 {
constexpr int BM = 256, BK = 64, HALF = 128, HTB = HALF * BK * 2, STAGE_BYTES = 8 * HTB, NXCD = 8, WGM = 8;
__device__ __forceinline__ int lds_byte(int r, int c) { const int st = (r >> 4) * 2 + (c >> 5), rr = r & 15, cc = c & 31, ob = rr * 64 + cc * 2; return st * 1024 + (ob ^ (((ob >> 9) & 1) << 5)); }
__device__ __forceinline__ void stage_rc(int b, int& R, int& C) { const int st = b / 1024, sb = b % 1024, swz = sb ^ (((sb >> 9) & 1) << 5); R = (st >> 1) * 16 + swz / 64; C = (st & 1) * 32 + (swz % 64) / 2; }
struct Unit { int pm, pn, seg; };
struct Gemm { const bf16_t *A0, *A1, *A2, *B0, *B1, *B2; int K; };
struct Sched {
    int nM, nN, nwg, G, c, nseg, extra, extraN, split;
    __device__ void init(int nM_, int nN_, int G_, int c_, int nseg_, int extra_, int extraN_, int split_ = 0) { nM = nM_; nN = nN_; nwg = nM * nN; G = G_; c = c_; nseg = nseg_; extra = extra_; extraN = extraN_; split = split_; }
    __device__ __forceinline__ bool next(int i, Unit& u) const {
        int ti = i, seg = 0;
        if (nseg == 3) { ti = i / 3; seg = i - ti * 3; }
        const long L = (long)ti * G + c;
        const bool ok = L < (long)(nwg + extra);
        const bool ex = L >= (long)nwg;
        const int e = (int)L - nwg;
        int wgid = ex ? 0 : (int)L; { const int q = nwg / NXCD, r = nwg % NXCD, xcd = wgid % NXCD, off = wgid / NXCD; wgid = (xcd < r ? xcd * (q + 1) : r * (q + 1) + (xcd - r) * q) + off; }
        const int nig = WGM * nN, gid = wgid / nig, fm = gid * WGM, gsz = (nM - fm) < WGM ? (nM - fm) : WGM;
        const int pm0 = fm + ((wgid % nig) % gsz), pn0 = (wgid % nig) / gsz;
        Unit r; r.pm = ex ? e / extraN : pm0; r.pn = ex ? e % extraN : pn0; r.seg = ex ? 1 : seg;
        if (split && ex) { r.pm = 32; r.seg = 1 + e / extraN; }
        if (!ok) { r.pm = 0; r.pn = 0; r.seg = 0; }
        u = r; return ok;
    }
};

template <class Epi>
__device__ __forceinline__ void gemm_phase(LAS unsigned char* lds, const Gemm g, const Sched& S, const Epi& E) {
    const int tid = otid(), wid = __builtin_amdgcn_readfirstlane(tid >> 6), lane = tid & 63, wr = wid >> 2, wc = wid & 3, fr = lane & 15, fq = lane >> 4;
    const int K = g.K, nt = K / BK;
    const char* const gA0 = (const char*)g.A0; const char* const gA1 = (const char*)g.A1; const char* const gA2 = (const char*)g.A2;
    const char* const gB0 = (const char*)g.B0; const char* const gB1 = (const char*)g.B1; const char* const gB2 = (const char*)g.B2;
#define GA(s) ((s) == 0 ? gA0 : ((s) == 1 ? gA1 : gA2))
#define GB(s) ((s) == 0 ? gB0 : ((s) == 1 ? gB1 : gB2))
    unsigned voffA[2];
#pragma unroll
    for (int i = 0; i < 2; ++i) { int R, C; stage_rc(tid * 16 + i * 8192, R, C); voffA[i] = (unsigned)(R * K + C) * 2u; }
    const size_t kstep = (size_t)(BK * 2);
    const size_t hstep = (size_t)HALF * K * 2;
    const size_t tstep = 2 * hstep;
    const unsigned ldsw = (unsigned)wid * 1024u;
    const int aoff = lds_byte(wr * 64 + fr, fq * 8), boff = lds_byte(wc * 32 + fr, fq * 8);
#define PG8_SA(b, h) (((b) * 2 + (h)) * HTB)
#define PG8_SB(b, h) ((4 + (b) * 2 + (h)) * HTB)
#define PG8_STAGE(bufoff, gbase, voff) do { _Pragma("unroll") for (int _i = 0; _i < 2; ++_i) \
        __builtin_amdgcn_global_load_lds((const unsigned*)((const char*)(gbase) + (voff)[_i]), (LAS unsigned*)(lds + (bufoff) + ldsw + _i * 8192), 16, 0, 0); } while (0)
#define PG8_LDA(dst, b, h) do { _Pragma("unroll") for (int m = 0; m < 4; ++m) _Pragma("unroll") for (int k = 0; k < 2; ++k) dst[m][k] = *(const LAS bf16x8*)(lds + PG8_SA(b, h) + aoff + m * 2048 + k * 1024); } while (0)
#define PG8_LDB(dst, b, h) do { _Pragma("unroll") for (int n = 0; n < 2; ++n) _Pragma("unroll") for (int k = 0; k < 2; ++k) dst[n][k] = *(const LAS bf16x8*)(lds + PG8_SB(b, h) + boff + n * 2048 + k * 1024); } while (0)
#define PG8_MMA(ai, bj, At, Bt) do { __builtin_amdgcn_s_setprio(1); _Pragma("unroll") for (int m = 0; m < 4; ++m) _Pragma("unroll") for (int n = 0; n < 2; ++n) _Pragma("unroll") for (int k = 0; k < 2; ++k) \
        acc[ai][bj][m][n] = __builtin_amdgcn_mfma_f32_16x16x32_bf16(Bt[n][k], At[m][k], acc[ai][bj][m][n], 0, 0, 0); __builtin_amdgcn_s_setprio(0); } while (0)
#define PG8_WAIT_V(n) asm volatile("s_waitcnt vmcnt(" #n ")" ::: "memory")
#define PG8_WAIT_L(n) asm volatile("s_waitcnt lgkmcnt(" #n ")" ::: "memory")
#define PG8_BAR __builtin_amdgcn_s_barrier()
#define PG8_SCHED __builtin_amdgcn_sched_barrier(0)
    Unit cur, nxt; int ui = 0;
    if (!S.next(0, cur)) return;
    f32x4 acc[2][2][4][2];
#pragma unroll
    for (int a = 0; a < 2; ++a)
#pragma unroll
        for (int b = 0; b < 2; ++b)
#pragma unroll
            for (int m = 0; m < 4; ++m)
#pragma unroll
                for (int n = 0; n < 2; ++n) acc[a][b][m][n] = (f32x4){0.f, 0.f, 0.f, 0.f};
    bf16x8 At[4][2], B0[2][2], B1[2][2];
#define UK0(u) ((S.split && (u).seg > 0) ? (size_t)((u).seg - 1) * S.split * kstep : (size_t)0)
    const char* cA = GA(cur.seg) + (size_t)cur.pm * tstep + UK0(cur); const char* cB = GB(cur.seg) + (size_t)cur.pn * tstep + UK0(cur);
    PG8_STAGE(PG8_SB(0, 0), cB, voffA); PG8_STAGE(PG8_SA(0, 0), cA, voffA); PG8_STAGE(PG8_SB(0, 1), cB + hstep, voffA); PG8_STAGE(PG8_SA(0, 1), cA + hstep, voffA);
    if (wr == 1) PG8_BAR;
    PG8_WAIT_V(4); PG8_BAR;
    PG8_STAGE(PG8_SB(1, 0), cB + kstep, voffA); PG8_STAGE(PG8_SA(1, 0), cA + kstep, voffA); PG8_STAGE(PG8_SB(1, 1), cB + hstep + kstep, voffA);
    PG8_WAIT_V(6); PG8_BAR;
    for (;;) {
        const bool has_next = S.next(ui + 1, nxt);
        const char* nA = has_next ? GA(nxt.seg) + (size_t)nxt.pm * tstep + UK0(nxt) : cA; const char* nB = has_next ? GB(nxt.seg) + (size_t)nxt.pn * tstep + UK0(nxt) : cB;
        const int ntu = (S.split && cur.seg > 0) ? S.split : nt;
        for (int t = 0; t < ntu; t += 2) {
            const bool last = (t == ntu - 2);
            const char* a1 = cA + (size_t)(t + 1) * kstep;
            const char* a2 = last ? nA : cA + (size_t)(t + 2) * kstep; const char* b2 = last ? nB : cB + (size_t)(t + 2) * kstep;
            const char* a3 = a2 + kstep; const char* b3 = b2 + kstep;
            PG8_LDB(B0, 0, 0); PG8_SCHED; PG8_LDA(At, 0, 0); PG8_STAGE(PG8_SA(1, 1), a1 + hstep, voffA);
            PG8_WAIT_L(8); PG8_BAR; PG8_WAIT_L(0); PG8_MMA(0, 0, At, B0); PG8_BAR; PG8_SCHED;
            PG8_LDB(B1, 0, 1); PG8_STAGE(PG8_SB(0, 0), b2, voffA);
            PG8_BAR; PG8_WAIT_L(0); PG8_MMA(0, 1, At, B1); PG8_BAR;
            PG8_LDA(At, 0, 1); PG8_STAGE(PG8_SA(0, 0), a2, voffA);
            PG8_BAR; PG8_WAIT_L(0); PG8_MMA(1, 0, At, B0); PG8_BAR; PG8_SCHED;
            PG8_STAGE(PG8_SB(0, 1), b2 + hstep, voffA);
            PG8_WAIT_V(6); PG8_BAR; PG8_MMA(1, 1, At, B1); PG8_BAR;
            PG8_LDB(B0, 1, 0); PG8_SCHED; PG8_LDA(At, 1, 0); PG8_STAGE(PG8_SA(0, 1), a2 + hstep, voffA);
            PG8_WAIT_L(8); PG8_BAR; PG8_WAIT_L(0); PG8_MMA(0, 0, At, B0); PG8_BAR; PG8_SCHED;
            PG8_LDB(B1, 1, 1); PG8_STAGE(PG8_SB(1, 0), b3, voffA);
            PG8_BAR; PG8_WAIT_L(0); PG8_MMA(0, 1, At, B1); PG8_BAR;
            PG8_LDA(At, 1, 1); PG8_STAGE(PG8_SA(1, 0), a3, voffA);
            PG8_BAR; PG8_WAIT_L(0); PG8_MMA(1, 0, At, B0); PG8_BAR; PG8_SCHED;
            PG8_STAGE(PG8_SB(1, 1), b3 + hstep, voffA);
            PG8_WAIT_V(6); PG8_BAR; PG8_MMA(1, 1, At, B1); PG8_BAR;
        }
        const bool keep = E(acc, cur, wr, wc, fr, fq, ui);
        if (!has_next) break;
        if (!keep) {
#pragma unroll
            for (int a = 0; a < 2; ++a)
#pragma unroll
                for (int b = 0; b < 2; ++b)
#pragma unroll
                    for (int m = 0; m < 4; ++m)
#pragma unroll
                        for (int n = 0; n < 2; ++n) acc[a][b][m][n] = (f32x4){0.f, 0.f, 0.f, 0.f};
        }
        cur = nxt; cA = nA; cB = nB; ++ui;
    }
    PG8_WAIT_V(0);
    if (wr == 0) PG8_BAR;
    PG8_BAR;
#undef GA
#undef GB
#undef UK0
#undef PG8_SA
#undef PG8_SB
#undef PG8_STAGE
#undef PG8_LDA
#undef PG8_LDB
#undef PG8_MMA
#undef PG8_WAIT_V
#undef PG8_WAIT_L
#undef PG8_BAR
#undef PG8_SCHED
}

template <class Epi>
__device__ __forceinline__ void gemm_simple(const Gemm g, const Sched& S, const Epi& E) {
    const int tid = otid(), wid = tid >> 6, lane = tid & 63, wr = wid >> 2, wc = wid & 3, fr = lane & 15, fq = lane >> 4;
    const int K = g.K;
    Unit cur; int ui = 0;
    f32x4 acc[2][2][4][2];
    bool keep = false;
    while (S.next(ui, cur)) {
        if (!keep) {
#pragma unroll
            for (int a = 0; a < 2; ++a)
#pragma unroll
                for (int b = 0; b < 2; ++b)
#pragma unroll
                    for (int m = 0; m < 4; ++m)
#pragma unroll
                        for (int n = 0; n < 2; ++n) acc[a][b][m][n] = (f32x4){0.f, 0.f, 0.f, 0.f};
        }
        const bf16_t* A = cur.seg == 0 ? g.A0 : (cur.seg == 1 ? g.A1 : g.A2); const bf16_t* B = cur.seg == 0 ? g.B0 : (cur.seg == 1 ? g.B1 : g.B2);
        const bf16_t* ap = A + (size_t)(cur.pm * 256 + wr * 64 + fr) * K + fq * 8;
        const bf16_t* bp = B + (size_t)(cur.pn * 256 + wc * 32 + fr) * K + fq * 8;
        for (int k0 = 0; k0 < K; k0 += 32) {
            bf16x8 af[2][4], bfr[2][2];
#pragma unroll
            for (int ai = 0; ai < 2; ++ai)
#pragma unroll
                for (int m = 0; m < 4; ++m) { union { u32x4 u; bf16x8 b; } t; t.u = ld16_sc1(ap + (size_t)(ai * 128 + m * 16) * K + k0); af[ai][m] = t.b; }
#pragma unroll
            for (int bj = 0; bj < 2; ++bj)
#pragma unroll
                for (int n = 0; n < 2; ++n) { union { u32x4 u; bf16x8 b; } t; t.u = ld16_sc1(bp + (size_t)(bj * 128 + n * 16) * K + k0); bfr[bj][n] = t.b; }
#pragma unroll
            for (int ai = 0; ai < 2; ++ai)
#pragma unroll
                for (int bj = 0; bj < 2; ++bj)
#pragma unroll
                    for (int m = 0; m < 4; ++m)
#pragma unroll
                        for (int n = 0; n < 2; ++n) acc[ai][bj][m][n] = __builtin_amdgcn_mfma_f32_16x16x32_bf16(bfr[bj][n], af[ai][m], acc[ai][bj][m][n], 0, 0, 0);
        }
        keep = E(acc, cur, wr, wc, fr, fq, ui);
        ++ui;
    }
}
}
using pg8::Unit;

#define EPI_ROWLOOP for (int ai = 0; ai < 2; ++ai) for (int m = 0; m < 4; ++m)
#define EPI_COLLOOP for (int bj = 0; bj < 2; ++bj) for (int n = 0; n < 2; ++n)

__device__ __forceinline__ void row_scales(const float* ps, int row0, int fq, float (&rr)[2][4]) {
#pragma unroll
    for (int ai = 0; ai < 2; ++ai) {
        f32x4 a[4], b[4];
#pragma unroll
        for (int m = 0; m < 4; ++m) { int row = row0 + ai * 128 + m * 16; row = row < MV ? row : MV - 1; const f32x4* q = (const f32x4*)(ps + (size_t)row * 32 + fq * 8); a[m] = q[0]; b[m] = q[1]; }
#pragma unroll
        for (int m = 0; m < 4; ++m) { const f32x4 t = a[m] + b[m]; float sm = (t[0] + t[1]) + (t[2] + t[3]); sm += __shfl_xor(sm, 16); sm += __shfl_xor(sm, 32); rr[ai][m] = rsqrtf(sm * (1.0f / 2048.0f) + EPSF); }
    }
}

struct EpiB {
    int l; const float* rsx; float* rsv; float* out; const LAS float* rsl;
    bf16_t *U, *Q, *KB, *VB, *MQ, *GT, *MKV; float* GV;
    __device__ __forceinline__ bool operator()(f32x4 (&acc)[2][2][4][2], const Unit& u, int wr, int wc, int fr, int fq, int ui) const {
        const int row0 = u.pm * 256 + wr * 64 + fr, cb = wc * 32 + 4 * fq;
        if (u.seg == 1) {
#pragma unroll
            EPI_ROWLOOP { const int row = row0 + ai * 128 + m * 16;
#pragma unroll
                EPI_COLLOOP { const int col = u.pn * 256 + bj * 128 + n * 16 + cb; const f32x4 v = acc[ai][bj][m][n];
                    float* o = out + (col < 512 ? O_MK : O_MV) + (size_t)l * (4 * 256 * 512) + (size_t)row * 512 + (col & 511);
                    *(f32x4*)o = v; *(u32x2*)(MKV + (size_t)row * 1024 + col) = pack4(v); } }
            return false;
        }
        float rr[2][4];
        if (ui < 6) {
#pragma unroll
            EPI_ROWLOOP rr[ai][m] = rsl[ui * 256 + ai * 128 + wr * 64 + m * 16 + fr];
        } else row_scales(rsx, row0, fq, rr);
        const int pn = u.pn;
        if (pn < 3) {
#pragma unroll
            EPI_ROWLOOP { const int row = row0 + ai * 128 + m * 16; if (row < MV) {
#pragma unroll
                EPI_COLLOOP { const int col = pn * 256 + bj * 128 + n * 16 + cb; f32x4 v = acc[ai][bj][m][n] * rr[ai][m];
                    v[0] = gelu_t(v[0]); v[1] = gelu_t(v[1]); v[2] = gelu_t(v[2]); v[3] = gelu_t(v[3]);
                    *(u32x2*)(U + (size_t)row * 768 + col) = pack4(v); } } }
        } else if (pn < 6) {
#pragma unroll
            EPI_ROWLOOP { const int row = row0 + ai * 128 + m * 16; float ss = 0.f;
#pragma unroll
                EPI_COLLOOP { const int col = (pn - 3) * 256 + bj * 128 + n * 16 + cb; f32x4 v = acc[ai][bj][m][n] * rr[ai][m];
                    v[0] = gelu_t(v[0]); v[1] = gelu_t(v[1]); v[2] = gelu_t(v[2]); v[3] = gelu_t(v[3]);
                    ss += v[0] * v[0] + v[1] * v[1] + v[2] * v[2] + v[3] * v[3];
                    if (row < MV) *(f32x4*)(GV + (size_t)row * 768 + col) = v; }
                ss += __shfl_xor(ss, 16); ss += __shfl_xor(ss, 32);
                if (fq == 0 && row < MV) rsv[(size_t)row * 16 + (pn - 3) * 4 + wc] = ss; }
        } else if (pn < 9) {
#pragma unroll
            EPI_ROWLOOP { const int row = row0 + ai * 128 + m * 16; if (row < MV) { const float sc = rr[ai][m] * 0.125f;
#pragma unroll
                EPI_COLLOOP { const int col = (pn - 6) * 256 + bj * 128 + n * 16 + cb;
                    *(u32x2*)(Q + (size_t)row * 768 + col) = pack4(acc[ai][bj][m][n] * sc); } } }
        } else if (pn < 11) {
            bf16_t* dst = pn == 9 ? KB : VB; const size_t obp = pn == 9 ? O_KP : O_VP, obs = pn == 9 ? O_KS : O_VS;
#pragma unroll
            EPI_ROWLOOP { const int row = row0 + ai * 128 + m * 16; if (row < MV) {
                float* o = nullptr;
                if (row >= TPR) o = out + obs + ((size_t)(l * 128 + (row - TPR)) * 128 + 127) * 256;
                else if ((row & 2047) >= 1920) o = out + obp + ((size_t)(l * 4 + (row >> 11)) * 128 + ((row & 2047) - 1920)) * 256;
#pragma unroll
                EPI_COLLOOP { const int col = bj * 128 + n * 16 + cb; const f32x4 v = acc[ai][bj][m][n] * rr[ai][m];
                    *(u32x2*)(dst + (size_t)row * 256 + col) = pack4(v);
                    if (o) *(f32x4*)(o + col) = v; } } }
        } else if (pn < 13) {
#pragma unroll
            EPI_ROWLOOP { const int row = row0 + ai * 128 + m * 16; if (row < MV) { const float sc = rr[ai][m] * 0.08838834764831845f;
#pragma unroll
                EPI_COLLOOP { const int col = (pn - 11) * 256 + bj * 128 + n * 16 + cb;
                    *(u32x2*)(MQ + (size_t)row * 512 + col) = pack4(acc[ai][bj][m][n] * sc); } } }
        } else {
#pragma unroll
            EPI_ROWLOOP { const int row = row0 + ai * 128 + m * 16; if (row < MV) {
#pragma unroll
                EPI_COLLOOP { const int col = (pn - 13) * 256 + bj * 128 + n * 16 + cb; f32x4 v = acc[ai][bj][m][n] * rr[ai][m];
                    v[0] = sigmoid_f(v[0]); v[1] = sigmoid_f(v[1]); v[2] = sigmoid_f(v[2]); v[3] = sigmoid_f(v[3]);
#ifdef DIAG_SYNGT
                    v = (f32x4){0.25f + 0.001f * (float)(row & 255), 0.5f, 0.75f, 0.125f + 0.002f * (float)(col & 127)};
#endif
                    *(u32x2*)(GT + (size_t)row * 6144 + col) = pack4(v); } } }
        }
        return false;
    }
};

struct EpiD {
    const bf16_t* GT; bf16_t* MG;
    __device__ __forceinline__ bool operator()(f32x4 (&acc)[2][2][4][2], const Unit& u, int wr, int wc, int fr, int fq, int ui) const {
        const int row0 = u.pm * 256 + wr * 64 + fr, cb = u.pn * 256 + wc * 32 + 4 * fq; const int s = u.seg;
        const int s1 = s < 2 ? s + 1 : s;
#pragma unroll
        for (int ai = 0; ai < 2; ++ai) {
            u32x2 ga[4][2][2], gb[4][2][2];
#pragma unroll
            for (int m = 0; m < 4; ++m) { int row = row0 + ai * 128 + m * 16; row = row < MV ? row : MV - 1; const bf16_t* gp = GT + (size_t)row * 6144 + cb;
#pragma unroll
                EPI_COLLOOP { ga[m][bj][n] = *(const u32x2*)(gp + s * 2048 + bj * 128 + n * 16); gb[m][bj][n] = *(const u32x2*)(gp + s1 * 2048 + bj * 128 + n * 16); } }
#pragma unroll
            for (int m = 0; m < 4; ++m) { const int row = row0 + ai * 128 + m * 16;
#pragma unroll
                EPI_COLLOOP { const int col = bj * 128 + n * 16 + cb;
                    f32x4 g = {bflo(ga[m][bj][n].x), bfhi(ga[m][bj][n].x), bflo(ga[m][bj][n].y), bfhi(ga[m][bj][n].y)};
                    if (s < 2) { const u32x2 b2 = gb[m][bj][n];
                        g[0] *= __builtin_amdgcn_rcpf(bflo(b2.x)); g[1] *= __builtin_amdgcn_rcpf(bfhi(b2.x)); g[2] *= __builtin_amdgcn_rcpf(bflo(b2.y)); g[3] *= __builtin_amdgcn_rcpf(bfhi(b2.y));
                        acc[ai][bj][m][n] *= g;
                    } else if (row < MV) { *(u32x2*)(MG + (size_t)row * 2048 + col) = pack4(acc[ai][bj][m][n] * g); } } }
        }
        return s < 2;
    }
};

__device__ __forceinline__ void st8c(float* q, float a, float b) { const unsigned long long v = (unsigned long long)__float_as_uint(a) | ((unsigned long long)__float_as_uint(b) << 32); __hip_atomic_store((unsigned long long*)q, v, __ATOMIC_RELAXED, __HIP_MEMORY_SCOPE_AGENT); }
struct EpiR {
    const float* xs0; const float* xs1;
    bf16_t* XB; float* rs;
    float* part; unsigned* ctr; int nc;
    __device__ __forceinline__ f32x4 ldres(int row, int col) const {
        if (xs0) return *(const f32x4*)((row < TPR ? xs0 + (size_t)row * 2048 : xs1 + (size_t)(row - TPR) * 2048) + col);
        const u32x2 t = *(const u32x2*)(XB + (size_t)row * 2048 + col); return (f32x4){bflo(t.x), bfhi(t.x), bflo(t.y), bfhi(t.y)};
    }
    __device__ __forceinline__ bool operator()(f32x4 (&acc)[2][2][4][2], const Unit& u, int wr, int wc, int fr, int fq, int ui) const {
        const int row0 = u.pm * 256 + wr * 64 + fr, cb = u.pn * 256 + wc * 32 + 4 * fq;
        if (u.seg > 0) {
            float* pp = part + ((size_t)(u.seg - 1) * 8 + u.pn) * (128 * 256) + (size_t)(wr * 64 + fr) * 256 + wc * 32 + 4 * fq;
#pragma unroll
            for (int m = 0; m < 4; ++m)
#pragma unroll
                EPI_COLLOOP { const f32x4 v = acc[0][bj][m][n]; float* q = pp + (size_t)(m * 16) * 256 + bj * 128 + n * 16; st8c(q, v[0], v[1]); st8c(q + 2, v[2], v[3]); }
            asm volatile("s_waitcnt vmcnt(0)" ::: "memory");
            unsigned old = 0;
            if (fr == 0 && fq == 0) old = __hip_atomic_fetch_add(ctr + u.pn * 8 + wr * 4 + wc, 1u, __ATOMIC_RELAXED, __HIP_MEMORY_SCOPE_AGENT);
            old = (unsigned)__builtin_amdgcn_readfirstlane((int)old);
            if (old != (unsigned)(nc - 1)) return false;
            const float* pb = part + (size_t)u.pn * (128 * 256) + (size_t)(wr * 64 + fr) * 256 + wc * 32 + 4 * fq;
            f32x4 sum[4][2][2];
#pragma unroll
            for (int m = 0; m < 4; ++m)
#pragma unroll
                EPI_COLLOOP sum[m][bj][n] = ldres(row0 + m * 16, cb + bj * 128 + n * 16);
            for (int ch = 0; ch < nc; ++ch) { const float* q = pb + (size_t)ch * (8 * 128 * 256);
                u32x2 lo[4][2][2], hi[4][2][2];
#pragma unroll
                for (int m = 0; m < 4; ++m)
#pragma unroll
                    EPI_COLLOOP { lo[m][bj][n] = ld8c(q + (size_t)(m * 16) * 256 + bj * 128 + n * 16); hi[m][bj][n] = ld8c(q + (size_t)(m * 16) * 256 + bj * 128 + n * 16 + 2); }
#pragma unroll
                for (int m = 0; m < 4; ++m)
#pragma unroll
                    EPI_COLLOOP sum[m][bj][n] += (f32x4){__uint_as_float(lo[m][bj][n].x), __uint_as_float(lo[m][bj][n].y), __uint_as_float(hi[m][bj][n].x), __uint_as_float(hi[m][bj][n].y)}; }
#pragma unroll
            for (int m = 0; m < 4; ++m) { const int row = row0 + m * 16; float ss = 0.f;
#pragma unroll
                EPI_COLLOOP { const int col = bj * 128 + n * 16 + cb; const f32x4 v = sum[m][bj][n];
                    *(u32x2*)(XB + (size_t)row * 2048 + col) = pack4(v);
                    ss += v[0] * v[0] + v[1] * v[1] + v[2] * v[2] + v[3] * v[3]; }
                ss += __shfl_xor(ss, 16); ss += __shfl_xor(ss, 32);
                if (fq == 0) rs[(size_t)row * 32 + u.pn * 4 + wc] = ss; }
            return false;
        }
#pragma unroll
        for (int ai = 0; ai < 2; ++ai) {
            f32x4 xv[4][2][2];
#pragma unroll
            for (int m = 0; m < 4; ++m) { int row = row0 + ai * 128 + m * 16; row = row < MV ? row : MV - 1;
#pragma unroll
                EPI_COLLOOP xv[m][bj][n] = ldres(row, cb + bj * 128 + n * 16); }
#pragma unroll
            for (int m = 0; m < 4; ++m) { const int row = row0 + ai * 128 + m * 16; float ss = 0.f;
#pragma unroll
                EPI_COLLOOP { const int col = bj * 128 + n * 16 + cb; const f32x4 v = xv[m][bj][n] + acc[ai][bj][m][n];
                    if (row < MV) *(u32x2*)(XB + (size_t)row * 2048 + col) = pack4(v);
                    ss += v[0] * v[0] + v[1] * v[1] + v[2] * v[2] + v[3] * v[3]; }
                ss += __shfl_xor(ss, 16); ss += __shfl_xor(ss, 32);
                if (fq == 0 && row < MV) rs[(size_t)row * 32 + u.pn * 4 + wc] = ss; }
        }
        return false;
    }
};

struct EpiF {
    int l; const float* rsf; bf16_t* H; float* out; const LAS float* rsl;
    __device__ __forceinline__ bool operator()(f32x4 (&acc)[2][2][4][2], const Unit& u, int wr, int wc, int fr, int fq, int ui) const {
        const int row0 = u.pm * 256 + wr * 64 + fr, cb = u.pn * 256 + wc * 32 + 4 * fq;
        float rr[2][4];
        if (ui < 6) {
#pragma unroll
            EPI_ROWLOOP rr[ai][m] = rsl[ui * 256 + ai * 128 + wr * 64 + m * 16 + fr];
        } else row_scales(rsf, row0, fq, rr);
#pragma unroll
        EPI_ROWLOOP { const int row = row0 + ai * 128 + m * 16; if (row < MV) {
            const float r = rr[ai][m];
            float* o = nullptr;
            if (row >= TPR) o = out + O_CS + ((size_t)(l * 128 + (row - TPR)) * 2 + 1) * DFF2;
            else if ((row & 2047) >= 2046) o = out + O_CP + ((size_t)(l * 4 + (row >> 11)) * 2 + ((row & 2047) - 2046)) * DFF2;
#pragma unroll
            EPI_COLLOOP { const int col = bj * 128 + n * 16 + cb; const f32x4 v = acc[ai][bj][m][n] * r;
                *(u32x2*)(H + (size_t)row * DFF2 + col) = pack4(v);
                if (o) *(f32x4*)(o + col) = v; } } }
        return false;
    }
};

__device__ __forceinline__ bool wjob(const Params& p, int tile, const float*& W, int& N, bf16_t*& Wt, int& ldk, const float*& g, int& kt, int& nt) {
    if (tile >= 15744) return false;
    const int l = tile >= 7872 ? 1 : 0; int t = tile - l * 7872;
    bf16_t* wb = (bf16_t*)(p.ws + WS_W) + (size_t)l * LW; g = nullptr;
    int K, nN;
    if (t < 2368) { W = p.in[9] + (size_t)l * 2048 * 9472; K = 2048; N = 9472; Wt = wb + oWIN; g = p.in[8] + l * 2048; }
    else if (t < 2624) { t -= 2368; W = p.in[15] + (size_t)l * 2048 * 1024; K = 2048; N = 1024; Wt = wb + oWMEM; }
    else if (t < 2816) { t -= 2624; W = p.in[16] + (size_t)l * 768 * 2048; K = 768; N = 2048; Wt = wb + oWBG; }
    else if (t < 3008) { t -= 2816; W = p.in[17] + (size_t)l * 768 * 2048; K = 768; N = 2048; Wt = wb + oWBA; }
    else if (t < 3136) { t -= 3008; W = p.in[18] + (size_t)l * 512 * 2048; K = 768; N = 2048; Wt = wb + oWBM; }
    else if (t < 3648) { t -= 3136; W = p.in[19] + (size_t)l * 2048 * 2048; K = 2048; N = 2048; Wt = wb + oWOUT; }
    else if (t < 6464) { t -= 3648; W = p.in[21] + (size_t)l * 2048 * DFF2; K = 2048; N = DFF2; Wt = wb + oWUP; g = p.in[20] + l * 2048; }
    else { t -= 6464; W = p.in[24] + (size_t)l * DFF * 2048; K = DFF; N = 2048; Wt = wb + oWDN; }
    ldk = K; nN = N / 128; kt = t / nN; nt = t - kt * nN;
    return true;
}

__device__ __forceinline__ void convert_tiles(const Params& p, LAS unsigned char* lds, int first, int last, int stride) {
    const int tid = otid();
    LAS bf16_t* T = (LAS bf16_t*)lds;
    f32x4 cur[4], nxt[4]; float gs[4], gsn[4];
    {
        const float* W; int N, ldk, kt, nt; bf16_t* Wt; const float* g;
        if ((first < last && wjob(p, first, W, N, Wt, ldk, g, kt, nt))) {
#pragma unroll
            for (int i = 0; i < 4; ++i) { const int idx = tid + i * 512, kk = idx >> 5, n4 = (idx & 31) * 4;
                cur[i] = *(const f32x4*)(W + (size_t)(kt * 64 + kk) * N + nt * 128 + n4); gs[i] = g ? g[kt * 64 + kk] : 1.0f; }
        }
    }
    for (int tile = first; tile < last; tile += stride) {
        const float* W; int N, ldk, kt, nt; bf16_t* Wt; const float* g;
        {
            const float* W2; int N2, ldk2, kt2, nt2; bf16_t* Wt2; const float* g2;
            if (tile + stride < last && wjob(p, tile + stride, W2, N2, Wt2, ldk2, g2, kt2, nt2)) {
#pragma unroll
                for (int i = 0; i < 4; ++i) { const int idx = tid + i * 512, kk = idx >> 5, n4 = (idx & 31) * 4;
                    nxt[i] = *(const f32x4*)(W2 + (size_t)(kt2 * 64 + kk) * N2 + nt2 * 128 + n4); gsn[i] = g2 ? g2[kt2 * 64 + kk] : 1.0f; }
            }
        }
        wjob(p, tile, W, N, Wt, ldk, g, kt, nt);
        const int k0 = kt * 64, n0 = nt * 128;
#pragma unroll
        for (int i = 0; i < 4; ++i) { const int idx = tid + i * 512, kk = idx >> 5, n4 = (idx & 31) * 4;
            const f32x4 v = cur[i] * gs[i];
            const unsigned a = cvt_pk_bf16(v[0], v[1]), b = cvt_pk_bf16(v[2], v[3]);
            T[(n4 + 0) * 72 + kk] = (bf16_t)(a & 0xffff); T[(n4 + 1) * 72 + kk] = (bf16_t)(a >> 16);
            T[(n4 + 2) * 72 + kk] = (bf16_t)(b & 0xffff); T[(n4 + 3) * 72 + kk] = (bf16_t)(b >> 16); }
        __syncthreads();
#pragma unroll
        for (int i = 0; i < 2; ++i) { const int idx = tid + i * 512, n = idx >> 3, kc = (idx & 7) * 8;
            const u32x4 v = *(const LAS u32x4*)(T + n * 72 + kc);
            *(u32x4*)(Wt + (size_t)(n0 + n) * ldk + k0 + kc) = v; }
        __syncthreads();
#pragma unroll
        for (int i = 0; i < 4; ++i) { cur[i] = nxt[i]; gs[i] = gsn[i]; }
    }
}

__device__ void phase0(const Params& p, LAS unsigned char* lds) {
    const int tid = otid(), lane = tid & 63, wid = tid >> 6;
    const int gw = blockIdx.x * 8 + wid, nw = gridDim.x * 8;
    float* rs = (float*)(p.ws + WS_RS);
    { float* psv = (float*)(p.ws + WS_PSV); for (int i = blockIdx.x * 512 + tid; i < MP * 4; i += gridDim.x * 512) psv[(size_t)(i >> 2) * 16 + 12 + (i & 3)] = 0.f; }
    {
        bf16_t* XB = (bf16_t*)(p.ws + WS_XB);
        for (int row = gw; row < MV; row += nw) {
            const float* src = row < TPR ? p.in[0] + (size_t)row * 2048 : p.in[1] + (size_t)(row - TPR) * 2048;
            float ss = 0.f; f32x4 xv8[8];
#pragma unroll
            for (int i = 0; i < 8; ++i) xv8[i] = *(const f32x4*)(src + (i * 64 + lane) * 4);
#pragma unroll
            for (int i = 0; i < 8; ++i) { const int c = (i * 64 + lane) * 4; const f32x4 v = xv8[i];
                ss += v[0] * v[0] + v[1] * v[1] + v[2] * v[2] + v[3] * v[3];
                *(u32x2*)(XB + (size_t)row * 2048 + c) = pack4(v); }
#pragma unroll
            for (int o = 32; o > 0; o >>= 1) ss += __shfl_xor(ss, o);
            if (lane < 32) rs[(size_t)row * 32 + lane] = lane == 0 ? ss : 0.f;
        }
    }
    {
        bf16_t* MN = (bf16_t*)(p.ws + WS_MEMN);
        for (int row = gw; row < 1024; row += nw) {
            const float* src = p.in[7] + (size_t)row * 2048; f32x4 v[8]; float ss = 0.f;
#pragma unroll
            for (int i = 0; i < 8; ++i) { v[i] = *(const f32x4*)(src + (i * 64 + lane) * 4); ss += v[i][0] * v[i][0] + v[i][1] * v[i][1] + v[i][2] * v[i][2] + v[i][3] * v[i][3]; }
#pragma unroll
            for (int o = 32; o > 0; o >>= 1) ss += __shfl_xor(ss, o);
            const float r = rsqrtf(ss * (1.0f / 2048.0f) + EPSF);
#pragma unroll
            for (int l = 0; l < 2; ++l)
#pragma unroll
                for (int i = 0; i < 8; ++i) { const int c = (i * 64 + lane) * 4; const f32x4 g = *(const f32x4*)(p.in[14] + l * 2048 + c);
                    *(u32x2*)(MN + ((size_t)l * 1024 + row) * 2048 + c) = pack4(v[i] * g * r); }
        }
    }
    for (int i0 = blockIdx.x * 512 + tid; i0 < 2 * 128 * (DFF2 / 4); i0 += 4 * gridDim.x * 512) {
        f32x4 cv4[4];
#pragma unroll
        for (int k = 0; k < 4; ++k) { const int i = i0 + k * gridDim.x * 512; cv4[k] = (f32x4){0.f, 0.f, 0.f, 0.f};
            if (i < 2 * 128 * (DFF2 / 4)) { const int ls = i / (DFF2 / 4), c = (i - ls * (DFF2 / 4)) * 4; cv4[k] = *(const f32x4*)(p.in[6] + ((size_t)ls * 2 + 1) * DFF2 + c); } }
#pragma unroll
        for (int k = 0; k < 4; ++k) { const int i = i0 + k * gridDim.x * 512;
            if (i < 2 * 128 * (DFF2 / 4)) { const int ls = i / (DFF2 / 4), c = (i - ls * (DFF2 / 4)) * 4; *(f32x4*)(p.out + O_CS + ((size_t)ls * 2 + 0) * DFF2 + c) = cv4[k]; } }
    }
    for (int i = blockIdx.x * 512 + tid; i < 2 * 2048 * 32; i += gridDim.x * 512) {
        const int l = i >> 16, r = (i >> 5) & 2047, c = (i & 31) * 8;
        *(u32x4*)((bf16_t*)(p.ws + WS_W) + (size_t)l * LW + oWBM + (size_t)r * 768 + 512 + c) = (u32x4){0u, 0u, 0u, 0u};
    }
    convert_tiles(p, lds, (int)blockIdx.x, 3648, (int)gridDim.x);
}

template <int HD, bool SWA>
__device__ __forceinline__ void attn_block16(const LAS bf16_t* Kl, const LAS bf16_t* VT, const bf16_t* qrow  ,
                                             bf16_t* orow0  , int ldo, int i0, bool first_blk, float slope, float sink) {
    constexpr int KS = HD + 8, VS = 264, NKS = HD / 32, NDB = HD / 16;
    const int lane = otid() & 63, r = lane & 15, quad = lane >> 4;
    bf16x8 qf[NKS];
#pragma unroll
    for (int ks = 0; ks < NKS; ++ks) qf[ks] = *(const bf16x8*)(qrow + ks * 32 + quad * 8);
    f32x4 st[16];
#pragma unroll
    for (int kb = 0; kb < 16; ++kb) { f32x4 a = {0.f, 0.f, 0.f, 0.f};
#pragma unroll
        for (int ks = 0; ks < NKS; ++ks) { const bf16x8 kf = *(const LAS bf16x8*)(Kl + (kb * 16 + r) * KS + ks * 32 + quad * 8);
            a = __builtin_amdgcn_mfma_f32_16x16x32_bf16(kf, qf[ks], a, 0, 0, 0); }
        st[kb] = a; __builtin_amdgcn_sched_barrier(0); }
    float mx = SWA ? sink : -INFINITY;
#pragma unroll
    for (int kb = 0; kb < 16; ++kb)
#pragma unroll
        for (int j = 0; j < 4; ++j) {
            if (SWA) { const int s = kb * 16 + quad * 4 + j, dist = i0 + r + 128 - s; const bool valid = dist >= 0 && dist <= 128 && (!first_blk || s >= 128);
                st[kb][j] = valid ? st[kb][j] - slope * (float)dist : -INFINITY; }
            mx = fmaxf(mx, st[kb][j]); }
    mx = fmaxf(mx, __shfl_xor(mx, 16)); mx = fmaxf(mx, __shfl_xor(mx, 32));
    float sum = 0.f;
#pragma unroll
    for (int kb = 0; kb < 16; ++kb)
#pragma unroll
        for (int j = 0; j < 4; ++j) { const float e = __expf(st[kb][j] - mx); st[kb][j] = e; sum += e; }
    sum += __shfl_xor(sum, 16); sum += __shfl_xor(sum, 32);
    if (SWA) sum += __expf(sink - mx);
    const float inv = __builtin_amdgcn_rcpf(sum);
    f32x4 o[NDB];
#pragma unroll
    for (int db = 0; db < NDB; ++db) o[db] = (f32x4){0.f, 0.f, 0.f, 0.f};
#pragma unroll
    for (int i = 0; i < 8; ++i) {
        union { bf16x8 v; unsigned u[4]; } pa;
        pa.u[0] = cvt_pk_bf16(st[2 * i][0] * inv, st[2 * i][1] * inv); pa.u[1] = cvt_pk_bf16(st[2 * i][2] * inv, st[2 * i][3] * inv);
        pa.u[2] = cvt_pk_bf16(st[2 * i + 1][0] * inv, st[2 * i + 1][1] * inv); pa.u[3] = cvt_pk_bf16(st[2 * i + 1][2] * inv, st[2 * i + 1][3] * inv);
#pragma unroll
        for (int db = 0; db < NDB; ++db) {
            union { bf16x8 v; u32x2 h[2]; } vb;
            vb.h[0] = *(const LAS u32x2*)(VT + (db * 16 + r) * VS + 32 * i + quad * 4);
            vb.h[1] = *(const LAS u32x2*)(VT + (db * 16 + r) * VS + 32 * i + 16 + quad * 4);
            o[db] = __builtin_amdgcn_mfma_f32_16x16x32_bf16(pa.v, vb.v, o[db], 0, 0, 0); }
        __builtin_amdgcn_sched_barrier(0); }
#pragma unroll
    for (int db = 0; db < NDB; ++db)
#pragma unroll
        for (int j = 0; j < 4; j += 2) { const unsigned pk = cvt_pk_bf16(o[db][j], o[db][j + 1]);
            orow0[(size_t)(quad * 4 + j) * ldo + db * 16 + r] = (bf16_t)(pk & 0xffff); orow0[(size_t)(quad * 4 + j + 1) * ldo + db * 16 + r] = (bf16_t)(pk >> 16); }
}

__device__ void mixer_phase(const Params& p, int l, LAS unsigned char* lds) {
    unsigned char* R1 = p.ws + WS_R1;
    const bf16_t* U = (const bf16_t*)(R1 + R_U); const float* GV = (const float*)(R1 + R_GV); const bf16_t* Q = (const bf16_t*)(R1 + R_Q);
    const bf16_t* KB = (const bf16_t*)(R1 + R_KB); const bf16_t* VB = (const bf16_t*)(R1 + R_VB); const bf16_t* MQ = (const bf16_t*)(R1 + R_MQ);
    bf16_t* OG = (bf16_t*)(R1 + R_OG); bf16_t* OA = (bf16_t*)(R1 + R_OA); bf16_t* OM = (bf16_t*)(R1 + R_OM);
    const bf16_t* MKV = (const bf16_t*)(p.ws + WS_MKV);
    const float* rsv = (const float*)(p.ws + WS_PSV);
    const float* sinks = p.in[13] + l * 12;
    float* out = p.out;
#ifndef MX
#define MX 0xff
#endif
    {
        if (MX & 1) for (int u = blockIdx.x; u < 256; u += gridDim.x) {
            const int tid = otid(), lane = tid & 63, wid = tid >> 6; (void)lane; (void)wid;
            const int b = u >> 6, nb = (u >> 2) & 15, kv = u & 3;
            LAS bf16_t* Kl = (LAS bf16_t*)lds; LAS bf16_t* VT = (LAS bf16_t*)(lds + 256 * 72 * 2);
#pragma unroll
            for (int i = 0; i < 4; ++i) { const int idx = tid + i * 512, s = idx >> 3, c8 = (idx & 7) * 8;
                const bool valid = nb > 0 || s >= 128; const size_t tok = (size_t)b * 2048 + nb * 128 - 128 + s;
                u32x4 kvv = {0u, 0u, 0u, 0u}, vv = {0u, 0u, 0u, 0u};
                if (valid) { kvv = *(const u32x4*)(KB + tok * 256 + kv * 64 + c8); vv = *(const u32x4*)(VB + tok * 256 + kv * 64 + c8); }
                *(LAS u32x4*)(Kl + s * 72 + c8) = kvv;
#pragma unroll
                for (int e = 0; e < 4; ++e) { VT[(c8 + 2 * e) * 264 + s] = (bf16_t)(vv[e] & 0xffff); VT[(c8 + 2 * e + 1) * 264 + s] = (bf16_t)(vv[e] >> 16); } }
            __syncthreads();
            const size_t tok0 = (size_t)b * 2048 + nb * 128 + wid * 16;
#pragma nounroll
            for (int g = 0; g < 3; ++g) { const int h = kv * 3 + g;
                attn_block16<64, true>(Kl, VT, Q + (tok0 + (lane & 15)) * 768 + h * 64, OA + tok0 * 768 + h * 64, 768, wid * 16, nb == 0, slope_of(h), sinks[h]); }
            __syncthreads();
        }
        if (MX & 2) for (int u = 256 + blockIdx.x; u < 512; u += gridDim.x) {
            const int tid = otid(), lane = tid & 63, wid = tid >> 6; (void)lane; (void)wid;
            const int v = u - 256, b = v >> 6, h = (v >> 4) & 3, qt = v & 15;
            LAS bf16_t* Kl = (LAS bf16_t*)lds; LAS bf16_t* VT = (LAS bf16_t*)(lds + 256 * 136 * 2);
#pragma unroll
            for (int i = 0; i < 8; ++i) { const int idx = tid + i * 512, s = idx >> 4, c8 = (idx & 15) * 8;
                const bf16_t* src = MKV + (size_t)(b * 256 + s) * 1024 + h * 128 + c8;
                const u32x4 kvv = *(const u32x4*)src, vv = *(const u32x4*)(src + 512);
                *(LAS u32x4*)(Kl + s * 136 + c8) = kvv;
#pragma unroll
                for (int e = 0; e < 4; ++e) { VT[(c8 + 2 * e) * 264 + s] = (bf16_t)(vv[e] & 0xffff); VT[(c8 + 2 * e + 1) * 264 + s] = (bf16_t)(vv[e] >> 16); } }
            __syncthreads();
            const size_t tok0 = (size_t)b * 2048 + qt * 128 + wid * 16;
            attn_block16<128, false>(Kl, VT, MQ + (tok0 + (lane & 15)) * 512 + h * 128, OM + tok0 * 768 + h * 128, 768, 0, false, 0.f, 0.f);
            __syncthreads();
        }
        if (MX & 4) for (int u = 512 + blockIdx.x; u < 1024; u += gridDim.x) {
            const int tid = otid(), lane = tid & 63, wid = tid >> 6; (void)lane; (void)wid;
            const int v = u - 512, b = v >> 7, ch = (v >> 3) & 15, g = v & 7;
            const size_t tok0 = (size_t)b * 2048 + ch * 128;
            LAS bf16_t* Wl = (LAS bf16_t*)lds; LAS bf16_t* VT = (LAS bf16_t*)(lds + 128 * 136 * 2);
            const float* wsrc = p.in[11] + ((size_t)l * 8 + g) * 128 * 128;
#pragma unroll
            for (int i = 0; i < 8; ++i) { const int idx = tid + i * 512, t = idx >> 5, s4 = (idx & 31) * 4;
                f32x4 w = *(const f32x4*)(wsrc + t * 128 + s4);
                w[0] = (s4 + 0 <= t) ? w[0] : 0.f; w[1] = (s4 + 1 <= t) ? w[1] : 0.f; w[2] = (s4 + 2 <= t) ? w[2] : 0.f; w[3] = (s4 + 3 <= t) ? w[3] : 0.f;
                *(LAS u32x2*)(Wl + t * 136 + s4) = pack4(w); }
#pragma unroll
            for (int i = 0; i < 6; ++i) { const int idx = tid + i * 512, s = idx / 24, c4 = (idx - s * 24) * 4;
                const float r = rsqrtf(rowsum16(rsv, (int)tok0 + s) * (1.0f / 768.0f) + EPSF);
                f32x4 vv = *(const f32x4*)(GV + (tok0 + s) * 768 + g * 96 + c4); const f32x4 gn = *(const f32x4*)(p.in[10] + l * 768 + g * 96 + c4);
                vv = vv * gn * r;
                if (ch == 15) *(f32x4*)(out + O_GVP + ((size_t)(l * 4 + b) * 128 + s) * 768 + g * 96 + c4) = vv;
                const u32x2 pk = pack4(vv);
                VT[(c4 + 0) * 136 + s] = (bf16_t)(pk.x & 0xffff); VT[(c4 + 1) * 136 + s] = (bf16_t)(pk.x >> 16);
                VT[(c4 + 2) * 136 + s] = (bf16_t)(pk.y & 0xffff); VT[(c4 + 3) * 136 + s] = (bf16_t)(pk.y >> 16); }
            __syncthreads();
            {
                const int r = lane & 15, quad = lane >> 4, t0 = wid * 16;
                f32x4 acc[6];
#pragma unroll
                for (int cbk = 0; cbk < 6; ++cbk) acc[cbk] = (f32x4){0.f, 0.f, 0.f, 0.f};
#pragma unroll
                for (int ks = 0; ks < 4; ++ks) { const bf16x8 a = *(const LAS bf16x8*)(Wl + (t0 + r) * 136 + ks * 32 + quad * 8);
#pragma unroll
                    for (int cbk = 0; cbk < 6; ++cbk) { const bf16x8 bb = *(const LAS bf16x8*)(VT + (cbk * 16 + r) * 136 + ks * 32 + quad * 8);
                        acc[cbk] = __builtin_amdgcn_mfma_f32_16x16x32_bf16(a, bb, acc[cbk], 0, 0, 0); } }
#pragma unroll
                for (int j = 0; j < 4; ++j) { const int t = t0 + quad * 4 + j; const float bs = p.in[12][((size_t)l * 8 + g) * 128 + t];
#pragma unroll
                    for (int cbk = 0; cbk < 6; ++cbk) { const size_t o = (tok0 + t) * 768 + g * 96 + cbk * 16 + r;
                        const float uu = bf2f(U[o]); OG[o] = (bf16_t)(cvt_pk_bf16(uu * (acc[cbk][j] + bs), 0.f) & 0xffff); } }
            }
            __syncthreads();
        }
        if (MX & 8) for (int u = 1024 + blockIdx.x; u < 1032; u += gridDim.x) {
            const int tid = otid(), lane = tid & 63, wid = tid >> 6; (void)lane; (void)wid;
            const int s0 = (u - 1024) * 16;
            for (int idx = tid; idx < 16 * 192; idx += 512) { const int s = s0 + idx / 192, c4 = (idx % 192) * 4, g = c4 / 96; const size_t row = TPR + s;
                const float r = rsqrtf(rowsum16(rsv, (int)row) * (1.0f / 768.0f) + EPSF);
                f32x4 vv = *(const f32x4*)(GV + row * 768 + c4); const f32x4 gn = *(const f32x4*)(p.in[10] + l * 768 + c4);
                vv = vv * gn * r;
                *(f32x4*)(out + O_GVS + ((size_t)l * 128 + s) * 768 + c4) = vv;
                const float w00 = p.in[11][((size_t)l * 8 + g) * 128 * 128], bs = p.in[12][((size_t)l * 8 + g) * 128];
                const u32x2 uu = *(const u32x2*)(U + row * 768 + c4);
                f32x4 o = {bflo(uu.x) * (w00 * vv[0] + bs), bfhi(uu.x) * (w00 * vv[1] + bs), bflo(uu.y) * (w00 * vv[2] + bs), bfhi(uu.y) * (w00 * vv[3] + bs)};
                *(u32x2*)(OG + row * 768 + c4) = pack4(o); }
        }
        if (MX & 16) for (int u = 1032 + blockIdx.x; u < 1544; u += gridDim.x) {
            const int tid = otid(), lane = tid & 63, wid = tid >> 6; (void)lane; (void)wid;
            const int v = u - 1032, s = v >> 2, kv = v & 3; const size_t row = TPR + s;
            LAS float* sc = (LAS float*)lds; LAS float* red = (LAS float*)(lds + 3 * 132 * 4);
            const float* ck = p.in[2] + (size_t)(l * 128 + s) * 128 * 256 + kv * 64; const float* cv = p.in[3] + (size_t)(l * 128 + s) * 128 * 256 + kv * 64;
            float* ok = out + O_KS + (size_t)(l * 128 + s) * 128 * 256 + kv * 64; float* ov = out + O_VS + (size_t)(l * 128 + s) * 128 * 256 + kv * 64;
            {
                const int c = lane & 15, q4 = lane >> 4; float qv[3][4];
#pragma unroll
                for (int g = 0; g < 3; ++g) { const u32x2 qq = *(const u32x2*)(Q + row * 768 + (kv * 3 + g) * 64 + c * 4); qv[g][0] = bflo(qq.x); qv[g][1] = bfhi(qq.x); qv[g][2] = bflo(qq.y); qv[g][3] = bfhi(qq.y); }
                f32x4 kk5[5];
#pragma unroll
                for (int ps = 0; ps < 5; ++ps) { const int j = ps * 32 + wid * 4 + q4; kk5[ps] = (f32x4){0.f, 0.f, 0.f, 0.f};
                    if (j <= 128) kk5[ps] = (j < 128) ? *(const f32x4*)(ck + (size_t)j * 256 + c * 4) : *(const f32x4*)(ok + (size_t)127 * 256 + c * 4); }
#pragma unroll
                for (int ps = 0; ps < 5; ++ps) { const int j = ps * 32 + wid * 4 + q4;
                    if (j <= 128) {
                        const f32x4 kk = kk5[ps];
                        if (j >= 1 && j < 128) *(f32x4*)(ok + (size_t)(j - 1) * 256 + c * 4) = kk;
                        float d0 = kk[0] * qv[0][0] + kk[1] * qv[0][1] + kk[2] * qv[0][2] + kk[3] * qv[0][3];
                        float d1 = kk[0] * qv[1][0] + kk[1] * qv[1][1] + kk[2] * qv[1][2] + kk[3] * qv[1][3];
                        float d2 = kk[0] * qv[2][0] + kk[1] * qv[2][1] + kk[2] * qv[2][2] + kk[3] * qv[2][3];
#pragma unroll
                        for (int o = 8; o > 0; o >>= 1) { d0 += __shfl_xor(d0, o); d1 += __shfl_xor(d1, o); d2 += __shfl_xor(d2, o); }
                        if (c == 0) { const float dist = (float)(128 - j);
                            sc[0 * 132 + j] = d0 - slope_of(kv * 3 + 0) * dist; sc[1 * 132 + j] = d1 - slope_of(kv * 3 + 1) * dist; sc[2 * 132 + j] = d2 - slope_of(kv * 3 + 2) * dist; } } }
            }
            __syncthreads();
            if (wid < 3) { const float sink = sinks[kv * 3 + wid]; LAS float* sr = sc + wid * 132;
                const float v0 = sr[lane], v1 = sr[lane + 64], v2 = lane == 0 ? sr[128] : -INFINITY;
                float mx = fmaxf(fmaxf(v0, v1), fmaxf(v2, sink));
#pragma unroll
                for (int o = 32; o > 0; o >>= 1) mx = fmaxf(mx, __shfl_xor(mx, o));
                const float e0 = __expf(v0 - mx), e1 = __expf(v1 - mx), e2 = lane == 0 ? __expf(v2 - mx) : 0.f;
                float sum = e0 + e1 + e2;
#pragma unroll
                for (int o = 32; o > 0; o >>= 1) sum += __shfl_xor(sum, o);
                sum += __expf(sink - mx); const float inv = 1.0f / sum;
                sr[lane] = e0 * inv; sr[lane + 64] = e1 * inv; if (lane == 0) sr[128] = e2 * inv; }
            __syncthreads();
            { const int jg = wid, d = lane; float a0 = 0.f, a1 = 0.f, a2 = 0.f;
                float vv17[17];
#pragma unroll
                for (int it = 0; it < 17; ++it) { const int j = jg + it * 8; vv17[it] = 0.f;
                    if (j <= 128) vv17[it] = (j < 128) ? cv[(size_t)j * 256 + d] : ov[(size_t)127 * 256 + d]; }
#pragma unroll
                for (int it = 0; it < 17; ++it) { const int j = jg + it * 8;
                    if (j <= 128) { const float vv = vv17[it];
                        if (j >= 1 && j < 128) ov[(size_t)(j - 1) * 256 + d] = vv;
                        a0 += sc[j] * vv; a1 += sc[132 + j] * vv; a2 += sc[264 + j] * vv; } }
                red[(jg * 3 + 0) * 64 + d] = a0; red[(jg * 3 + 1) * 64 + d] = a1; red[(jg * 3 + 2) * 64 + d] = a2; }
            __syncthreads();
            if (tid < 192) { const int g = tid >> 6, d = tid & 63; float a = 0.f;
#pragma unroll
                for (int jg = 0; jg < 8; ++jg) a += red[(jg * 3 + g) * 64 + d];
                OA[row * 768 + (kv * 3 + g) * 64 + d] = (bf16_t)(cvt_pk_bf16(a, 0.f) & 0xffff); }
            __syncthreads();
        }
        if (MX & 32) for (int u = 1544 + blockIdx.x; u < 2056; u += gridDim.x) {
            const int tid = otid(), lane = tid & 63, wid = tid >> 6; (void)lane; (void)wid;
            const int v = u - 1544, s = v >> 2, h = v & 3; const size_t row = TPR + s;
            LAS float* sc = (LAS float*)lds; LAS float* red = (LAS float*)(lds + 256 * 4);
            const float* ck = p.in[4] + (size_t)(l * 128 + s) * 256 * 512 + h * 128; const float* cv = p.in[5] + (size_t)(l * 128 + s) * 256 * 512 + h * 128;
            {
                const int c = lane & 31, q2 = lane >> 5; const u32x2 qq = *(const u32x2*)(MQ + row * 512 + h * 128 + c * 4);
                const float q0 = bflo(qq.x), q1 = bfhi(qq.x), q2f = bflo(qq.y), q3 = bfhi(qq.y);
#pragma unroll
                for (int ps = 0; ps < 16; ++ps) { const int m = ps * 16 + wid * 2 + q2; const f32x4 kk = *(const f32x4*)(ck + (size_t)m * 512 + c * 4);
                    float d = kk[0] * q0 + kk[1] * q1 + kk[2] * q2f + kk[3] * q3;
#pragma unroll
                    for (int o = 16; o > 0; o >>= 1) d += __shfl_xor(d, o);
                    if (c == 0) sc[m] = d; }
            }
            __syncthreads();
            if (wid == 0) { const float v0 = sc[lane], v1 = sc[lane + 64], v2 = sc[lane + 128], v3 = sc[lane + 192];
                float mx = fmaxf(fmaxf(v0, v1), fmaxf(v2, v3));
#pragma unroll
                for (int o = 32; o > 0; o >>= 1) mx = fmaxf(mx, __shfl_xor(mx, o));
                const float e0 = __expf(v0 - mx), e1 = __expf(v1 - mx), e2 = __expf(v2 - mx), e3 = __expf(v3 - mx);
                float sum = e0 + e1 + e2 + e3;
#pragma unroll
                for (int o = 32; o > 0; o >>= 1) sum += __shfl_xor(sum, o);
                const float inv = 1.0f / sum;
                sc[lane] = e0 * inv; sc[lane + 64] = e1 * inv; sc[lane + 128] = e2 * inv; sc[lane + 192] = e3 * inv; }
            __syncthreads();
            { const int mg = tid >> 5, c = tid & 31; f32x4 a = {0.f, 0.f, 0.f, 0.f};
#pragma unroll
                for (int it = 0; it < 16; ++it) { const int m = mg + it * 16; const f32x4 vv = *(const f32x4*)(cv + (size_t)m * 512 + c * 4); a += vv * sc[m]; }
                *(LAS f32x4*)(red + mg * 128 + c * 4) = a; }
            __syncthreads();
            if (tid < 128) { float a = 0.f;
#pragma unroll
                for (int mg = 0; mg < 16; ++mg) a += red[mg * 128 + tid];
                OM[row * 768 + h * 128 + tid] = (bf16_t)(cvt_pk_bf16(a, 0.f) & 0xffff); }
            __syncthreads();
        }
    }
}

__device__ void conv_phase(const Params& p, int l) {
    const bf16_t* H = (const bf16_t*)(p.ws + WS_R1 + R_H); bf16_t* ACT = (bf16_t*)(p.ws + WS_ACT);
    const float* cw = p.in[22] + (size_t)l * 3 * DFF2; const float* cb = p.in[23] + (size_t)l * DFF2;
    constexpr int NJ = DFF / 8;
    const int nitems = 256 * NJ + 128 * NJ;
    for (int it = blockIdx.x * 512 + otid(); it < nitems; it += gridDim.x * 512) {
        const bool samp = it >= 256 * NJ; const int it2 = samp ? it - 256 * NJ : it; const int rb = it2 / NJ, j = (it2 - rb * NJ) * 8;
        float w[2][3][8], bias[2][8], h1[2][8], h2[2][8];
#pragma unroll
        for (int ab = 0; ab < 2; ++ab) {
#pragma unroll
            for (int k = 0; k < 3; ++k) { const f32x4 x0 = *(const f32x4*)(cw + (size_t)k * DFF2 + ab * DFF + j), x1 = *(const f32x4*)(cw + (size_t)k * DFF2 + ab * DFF + j + 4);
#pragma unroll
                for (int e = 0; e < 4; ++e) { w[ab][k][e] = x0[e]; w[ab][k][4 + e] = x1[e]; } }
            const f32x4 b0 = *(const f32x4*)(cb + ab * DFF + j), b1 = *(const f32x4*)(cb + ab * DFF + j + 4);
#pragma unroll
            for (int e = 0; e < 4; ++e) { bias[ab][e] = b0[e]; bias[ab][4 + e] = b1[e]; } }
        int row0, nrows;
        if (samp) { row0 = TPR + rb; nrows = 1;
#pragma unroll
            for (int ab = 0; ab < 2; ++ab) { const float* st = p.in[6] + ((size_t)(l * 128 + rb) * 2) * DFF2 + ab * DFF + j;
                const f32x4 a0 = *(const f32x4*)(st), a1 = *(const f32x4*)(st + 4), c0 = *(const f32x4*)(st + DFF2), c1 = *(const f32x4*)(st + DFF2 + 4);
#pragma unroll
                for (int e = 0; e < 4; ++e) { h2[ab][e] = a0[e]; h2[ab][4 + e] = a1[e]; h1[ab][e] = c0[e]; h1[ab][4 + e] = c1[e]; } }
        } else { row0 = rb * 32; nrows = 32; const bool first = (row0 & 2047) == 0;
#pragma unroll
            for (int ab = 0; ab < 2; ++ab) {
                u32x4 a = {0u, 0u, 0u, 0u}, c = {0u, 0u, 0u, 0u};
                if (!first) { a = *(const u32x4*)(H + (size_t)(row0 - 2) * DFF2 + ab * DFF + j); c = *(const u32x4*)(H + (size_t)(row0 - 1) * DFF2 + ab * DFF + j); }
#pragma unroll
                for (int e = 0; e < 4; ++e) { h2[ab][2 * e] = bflo(a[e]); h2[ab][2 * e + 1] = bfhi(a[e]); h1[ab][2 * e] = bflo(c[e]); h1[ab][2 * e + 1] = bfhi(c[e]); } }
        }
        for (int r0 = 0; r0 < nrows; r0 += 8) {
            u32x4 hav[8], hbv[8];
#pragma unroll
            for (int i = 0; i < 8; ++i) { hav[i] = (u32x4){0u, 0u, 0u, 0u}; hbv[i] = hav[i];
                if (r0 + i < nrows) { const size_t row = (size_t)row0 + r0 + i; hav[i] = *(const u32x4*)(H + row * DFF2 + j); hbv[i] = *(const u32x4*)(H + row * DFF2 + DFF + j); } }
#pragma unroll
            for (int i = 0; i < 8; ++i) if (r0 + i < nrows) { const size_t row = (size_t)row0 + r0 + i; const u32x4 ha = hav[i], hb = hbv[i];
                float h0[2][8];
#pragma unroll
                for (int e = 0; e < 4; ++e) { h0[0][2 * e] = bflo(ha[e]); h0[0][2 * e + 1] = bfhi(ha[e]); h0[1][2 * e] = bflo(hb[e]); h0[1][2 * e + 1] = bfhi(hb[e]); }
                float o[8];
#pragma unroll
                for (int e = 0; e < 8; ++e) {
                    const float a = bias[0][e] + h2[0][e] * w[0][0][e] + h1[0][e] * w[0][1][e] + h0[0][e] * w[0][2][e];
                    const float b = bias[1][e] + h2[1][e] * w[1][0][e] + h1[1][e] * w[1][1][e] + h0[1][e] * w[1][2][e];
                    o[e] = gelu_t(a) * b; h2[0][e] = h1[0][e]; h1[0][e] = h0[0][e]; h2[1][e] = h1[1][e]; h1[1][e] = h0[1][e]; }
                u32x4 pk = {cvt_pk_bf16(o[0], o[1]), cvt_pk_bf16(o[2], o[3]), cvt_pk_bf16(o[4], o[5]), cvt_pk_bf16(o[6], o[7])};
                *(u32x4*)(ACT + row * DFF + j) = pk; }
        }
    }
}

__device__ void final_phase(const Params& p, const float* rs) {
    const int tidf = otid(), lane = tidf & 63, gw = blockIdx.x * 8 + (tidf >> 6), nw = gridDim.x * 8;
    const bf16_t* XBf = (const bf16_t*)(p.ws + WS_XB); const float* g = p.in[25];
    for (int row = gw; row < MV; row += nw) { const float r = rsqrtf(rowsum32(rs, row) * (1.0f / 2048.0f) + EPSF);
        u32x2 t8[8];
#pragma unroll
        for (int i = 0; i < 8; ++i) t8[i] = *(const u32x2*)(XBf + (size_t)row * 2048 + (i * 64 + lane) * 4);
#pragma unroll
        for (int i = 0; i < 8; ++i) { const int c = (i * 64 + lane) * 4; const u32x2 t = t8[i]; const f32x4 v = {bflo(t.x), bfhi(t.x), bflo(t.y), bfhi(t.y)}, gg = *(const f32x4*)(g + c);
            *(f32x4*)(p.out + O_Y + (size_t)row * 2048 + c) = v * gg * r; } }
}

__device__ __forceinline__ void fill_row_scales(const pg8::Sched& S, const float* ps, LAS float* rsl) {
    const int t = otid(), half = t >> 8, tr = t & 255;
#pragma unroll 1
    for (int i = half; i < 6; i += 2) { Unit u; const bool ok = S.next(i, u);
        if (ok) { int row = u.pm * 256 + tr; row = row < MV ? row : MV - 1; const f32x4* q = (const f32x4*)(ps + (size_t)row * 32);
            f32x4 a = q[0];
#pragma unroll
            for (int k = 1; k < 8; ++k) a += q[k];
            rsl[i * 256 + tr] = rsqrtf(((a[0] + a[1]) + (a[2] + a[3])) * (1.0f / 2048.0f) + EPSF); } }
    __syncthreads();
}

__device__ __forceinline__ void branch_rows_skinny(const bf16_t* OG, const bf16_t* OA, const bf16_t* OM, const bf16_t* WG, const bf16_t* WA, const bf16_t* WM,
                                                   const bf16_t* GT, bf16_t* MG, int c) {
    const int t = otid(), lane = t & 63, w = t >> 6, r = lane & 15, quad = lane >> 4;
    const int col0 = c * 16;
    f32x4 m = {0.f, 0.f, 0.f, 0.f};
#pragma unroll 1
    for (int s = 0; s < 3; ++s) {
        const bf16_t* A = (s == 0 ? OG : (s == 1 ? OA : OM)) + (size_t)(TPR + w * 16 + r) * 768 + quad * 8;
        const bf16_t* B = (s == 0 ? WG : (s == 1 ? WA : WM)) + (size_t)(col0 + r) * 768 + quad * 8;
        const int kend = s == 2 ? 512 : 768;
        f32x4 acc = {0.f, 0.f, 0.f, 0.f};
#pragma unroll 8
        for (int k0 = 0; k0 < kend; k0 += 32) { const bf16x8 a = *(const bf16x8*)(A + k0), b = *(const bf16x8*)(B + k0); acc = __builtin_amdgcn_mfma_f32_16x16x32_bf16(a, b, acc, 0, 0, 0); }
#pragma unroll
        for (int j = 0; j < 4; ++j) { const size_t row = (size_t)(TPR + w * 16 + quad * 4 + j); m[j] += bf2f(GT[row * 6144 + s * 2048 + col0 + r]) * acc[j]; }
    }
#pragma unroll
    for (int j = 0; j < 4; ++j) { const size_t row = (size_t)(TPR + w * 16 + quad * 4 + j); MG[row * 2048 + col0 + r] = (bf16_t)(cvt_pk_bf16(m[j], 0.f) & 0xffff); }
}

#ifdef SIMPLE_GEMM
#define GEMM_CALL(lds, g, S, E) pg8::gemm_simple(g, S, E)
#else
#define GEMM_CALL(lds, g, S, E) pg8::gemm_phase(lds, g, S, E)
#endif
template <int SUB> __device__ __forceinline__ void run_sub(const Params& p, int l, LAS unsigned char* lds) {
    const int G = gridDim.x, c = blockIdx.x; (void)G; (void)c;
    unsigned char* ws = p.ws; unsigned char* R1 = ws + WS_R1; (void)R1;
    float* rs = (float*)(ws + WS_RS); (void)rs;
    constexpr int sub = SUB; constexpr int ph = SUB < 0 ? 0 : 1;
        const bf16_t* wb = (const bf16_t*)(ws + WS_W) + (size_t)l * LW;
        if constexpr (sub < 0) phase0(p, lds);
        else if constexpr (sub == 0) {
            pg8::Gemm g; g.A0 = (const bf16_t*)(ws + WS_XB); g.B0 = wb + oWIN; g.A1 = (const bf16_t*)(ws + WS_MEMN) + (size_t)l * 1024 * 2048; g.B1 = wb + oWMEM; g.A2 = g.A0; g.B2 = g.B0; g.K = 2048;
            pg8::Sched S; S.init(33, 37, G, c, 1, 16, 4);
            EpiB E; E.l = l; E.rsx = rs; E.rsv = (float*)(ws + WS_PSV); E.out = p.out;
            E.U = (bf16_t*)(R1 + R_U); E.Q = (bf16_t*)(R1 + R_Q); E.KB = (bf16_t*)(R1 + R_KB); E.VB = (bf16_t*)(R1 + R_VB); E.MQ = (bf16_t*)(R1 + R_MQ); E.GT = (bf16_t*)(R1 + R_GT);
            E.MKV = (bf16_t*)(ws + WS_MKV); E.GV = (float*)(R1 + R_GV);
            E.rsl = (const LAS float*)(lds + pg8::STAGE_BYTES); fill_row_scales(S, rs, (LAS float*)(lds + pg8::STAGE_BYTES));
            GEMM_CALL(lds, g, S, E);
        } else if constexpr (sub == 1) mixer_phase(p, l, lds);
        else if constexpr (sub == 2) {
            pg8::Gemm g; g.A0 = (const bf16_t*)(R1 + R_OG); g.A1 = (const bf16_t*)(R1 + R_OA); g.A2 = (const bf16_t*)(R1 + R_OM); g.B0 = wb + oWBG; g.B1 = wb + oWBA; g.B2 = wb + oWBM; g.K = 768;
            pg8::Sched S; S.init(32, 8, G, c, 3, 0, 1);
            EpiD E; E.GT = (const bf16_t*)(R1 + R_GT); E.MG = (bf16_t*)(ws + WS_MG);
            GEMM_CALL(lds, g, S, E);
            for (int cc = c; cc < 128; cc += G) branch_rows_skinny(g.A0, g.A1, g.A2, g.B0, g.B1, g.B2, E.GT, E.MG, cc);
            if (l == 0) { __syncthreads(); convert_tiles(p, lds, 3648 + c, 6464, G); convert_tiles(p, lds, 7872 + c, 11776, G); }
        } else if constexpr (sub == 3) {
            pg8::Gemm g; g.A0 = g.A1 = g.A2 = (const bf16_t*)(ws + WS_MG); g.B0 = g.B1 = g.B2 = wb + oWOUT; g.K = 2048;
            pg8::Sched S; S.init(32, 8, G, c, 1, 4 * 8, 8, 8);
            EpiR E; E.xs0 = l == 0 ? p.in[0] : nullptr; E.xs1 = l == 0 ? p.in[1] : nullptr;
            E.XB = (bf16_t*)(ws + WS_XB); E.rs = rs;
            E.part = (float*)(ws + WS_PART) + (size_t)(l * 2) * (22 * 8 * 128 * 256); E.ctr = (unsigned*)(ws + WS_BAR) + 768 + (l * 2) * 64; E.nc = 4;
            GEMM_CALL(lds, g, S, E);
            if (l == 0 && c >= 32) { __syncthreads(); convert_tiles(p, lds, 6464 + (c - 32), 7872, G - 32); }
        } else if constexpr (sub == 4) {
            pg8::Gemm g; g.A0 = g.A1 = g.A2 = (const bf16_t*)(ws + WS_XB); g.B0 = g.B1 = g.B2 = wb + oWUP; g.K = 2048;
            pg8::Sched S; S.init(33, 44, G, c, 1, 0, 1);
            EpiF E; E.l = l; E.rsf = rs; E.H = (bf16_t*)(R1 + R_H); E.out = p.out;
            E.rsl = (const LAS float*)(lds + pg8::STAGE_BYTES); fill_row_scales(S, rs, (LAS float*)(lds + pg8::STAGE_BYTES));
            GEMM_CALL(lds, g, S, E);
        } else if constexpr (sub == 5) conv_phase(p, l);
        else if constexpr (sub == 6) {
            pg8::Gemm g; g.A0 = g.A1 = g.A2 = (const bf16_t*)(ws + WS_ACT); g.B0 = g.B1 = g.B2 = wb + oWDN; g.K = DFF;
            pg8::Sched S; S.init(32, 8, G, c, 1, 4 * 8, 8, 22);
            EpiR E; E.xs0 = nullptr; E.xs1 = nullptr;
            E.XB = (bf16_t*)(ws + WS_XB); E.rs = rs;
            E.part = (float*)(ws + WS_PART) + (size_t)(l * 2 + 1) * (22 * 8 * 128 * 256); E.ctr = (unsigned*)(ws + WS_BAR) + 768 + (l * 2 + 1) * 64; E.nc = 4;
            GEMM_CALL(lds, g, S, E);
            if (l == 0 && c >= 32) { __syncthreads(); convert_tiles(p, lds, 11776 + (c - 32), 15744, G - 32); }
        } else final_phase(p, rs);
}
template <int SUB> __global__ void __launch_bounds__(512) k_sub(Params p) {
    extern __shared__ __attribute__((aligned(16))) unsigned char shm[];
    run_sub<SUB>(p, p.ph_lo, (LAS unsigned char*)shm);
}
#ifndef ONE_LAUNCH
#define ONE_LAUNCH 1
#endif
__global__ void __launch_bounds__(512) fwd_mk(Params p) {
    extern __shared__ __attribute__((aligned(16))) unsigned char shm[];
    LAS unsigned char* lds = (LAS unsigned char*)shm;
    cg::grid_group grid = cg::this_grid();
    unsigned* gb = (unsigned*)(p.ws + WS_BAR); unsigned gb_target = 0, gb_k = 0, gb_nx = 0;
    const unsigned gb_x = (unsigned)__builtin_amdgcn_s_getreg((3 << 11) | 20) & 0xFu;
    if (p.ws == nullptr) grid.sync();
#define GB_LD(pw) __hip_atomic_load((pw), __ATOMIC_RELAXED, __HIP_MEMORY_SCOPE_AGENT)
#define GB_ADD(pw, v) __hip_atomic_fetch_add((pw), (v), __ATOMIC_RELAXED, __HIP_MEMORY_SCOPE_AGENT)
#define GSYNC() do { gb_target += gridDim.x; ++gb_k; \
        asm volatile("s_waitcnt vmcnt(0)" ::: "memory"); __syncthreads(); \
        if (threadIdx.x < 64) { \
            if (gb_k == 1) { \
                __builtin_amdgcn_fence(__ATOMIC_RELEASE, "agent"); asm volatile("s_waitcnt vmcnt(0)" ::: "memory"); \
                if (threadIdx.x == 0) { GB_ADD(gb + 64 + 16 * gb_x, 1u); GB_ADD(gb, 1u); \
                    while (GB_LD(gb) < gb_target) __builtin_amdgcn_s_sleep(1); \
                    gb_nx = GB_LD(gb + 64 + 16 * gb_x); } \
            } else if (threadIdx.x == 0) { \
                const unsigned old = GB_ADD(gb + 384 + 16 * gb_x, 1u); \
                if (old + 1u == gb_nx * (gb_k - 1u)) { __builtin_amdgcn_fence(__ATOMIC_RELEASE, "agent"); asm volatile("s_waitcnt vmcnt(0)" ::: "memory"); GB_ADD(gb, gb_nx); } \
                while (GB_LD(gb) < gb_target) __builtin_amdgcn_s_sleep(1); \
            } \
            __builtin_amdgcn_fence(__ATOMIC_ACQUIRE, "agent"); asm volatile("s_waitcnt vmcnt(0)" ::: "memory"); } \
        __syncthreads(); } while (0)
    run_sub<-1>(p, 0, lds); GSYNC();
    for (int l = 0; l < 2; ++l) {
        run_sub<0>(p, l, lds); GSYNC();
        run_sub<1>(p, l, lds); GSYNC();
        run_sub<2>(p, l, lds); GSYNC();
        run_sub<3>(p, l, lds); GSYNC();
        run_sub<4>(p, l, lds); GSYNC();
        run_sub<5>(p, l, lds); GSYNC();
        run_sub<6>(p, l, lds); GSYNC();
    }
    run_sub<7>(p, 0, lds);
}
template <int SUB> static void launch_sub(const Params& p0, int l, int grid, hipStream_t stream) {
    static bool attr = false; if (!attr) { (void)hipFuncSetAttribute((const void*)k_sub<SUB>, hipFuncAttributeMaxDynamicSharedMemorySize, LDS_BYTES); attr = true; }
    Params p = p0; p.ph_lo = l; p.ph_hi = 0;
    hipLaunchKernelGGL(k_sub<SUB>, dim3(grid), dim3(512), LDS_BYTES, stream, p);
}

extern "C" void kernel_launch(void* const* d_in, const int* in_sizes, int n_in, void* d_out, int out_size, void* d_ws, size_t ws_size, hipStream_t stream) {
    static int grid_blocks = 0;
    if (!grid_blocks) {
        int dev = 0, cus = 0;
        (void)hipGetDevice(&dev);
        (void)hipDeviceGetAttribute(&cus, hipDeviceAttributeMultiprocessorCount, dev);
        grid_blocks = cus > 0 ? cus : 256;
    }
    if (ws_size < WS_END) return;
    Params p{};
    for (int i = 0; i < 26; ++i) p.in[i] = (const float*)d_in[i];
    p.out = (float*)d_out; p.ws = (unsigned char*)d_ws;
    if (ONE_LAUNCH) {
#ifdef REP_MASK
        p.ph_hi = REP_MASK;
#endif
        static bool attr = false; if (!attr) { (void)hipFuncSetAttribute((const void*)fwd_mk, hipFuncAttributeMaxDynamicSharedMemorySize, LDS_BYTES); attr = true; }
        (void)hipMemsetAsync((char*)d_ws + WS_BAR, 0, 4096, stream);
        void* args[] = {&p};
        hipError_t e = hipLaunchCooperativeKernel((void*)fwd_mk, dim3(grid_blocks), dim3(512), args, LDS_BYTES, stream);
        if (e != hipSuccess) fprintf(stderr, "cooperative launch failed: %s (grid %d)\n", hipGetErrorString(e), grid_blocks);
        return;
    }
    launch_sub<-1>(p, 0, grid_blocks, stream);
    for (int l = 0; l < 2; ++l) {
        launch_sub<0>(p, l, grid_blocks, stream); launch_sub<1>(p, l, grid_blocks, stream); launch_sub<2>(p, l, grid_blocks, stream); launch_sub<3>(p, l, grid_blocks, stream);
        launch_sub<4>(p, l, grid_blocks, stream); launch_sub<5>(p, l, grid_blocks, stream); launch_sub<6>(p, l, grid_blocks, stream);
    }
    launch_sub<7>(p, 0, grid_blocks, stream);
}
```
